# Optimizing an MI355X kernel written in HIP

```python
import jax, jax.numpy as jnp
from jax import lax
import numpy as np

D_MODEL = 4096
BATCH = 1
SEQ = 16384
DEPTH = 1

MIX_DIM = D_MODEL
RET_DIM = MIX_DIM // 2
POOL_DIM = MIX_DIM - RET_DIM
RET_HEADS = 8
RET_HEAD_DIM = RET_DIM // RET_HEADS
POOL_WINDOWS = (2, 4, 8, 16)
POOL_GROUPS = len(POOL_WINDOWS)
POOL_GROUP_DIM = POOL_DIM // POOL_GROUPS
PROJ_DIM = 4 * RET_DIM + POOL_DIM
D_FF = ((8 * D_MODEL // 3 + 255) // 256) * 256
CHUNK = 128
ROPE_BASE = 10000.0
EPS = 1e-6

kernel_name = 'hybrid_retention_pool_macaron_encoder'


def _rmsnorm(x, gain):
    xf = x.astype(jnp.float32)
    y = xf * lax.rsqrt(jnp.mean(xf * xf, axis=-1, keepdims=True) + EPS)
    return (y * gain.astype(jnp.float32)).astype(x.dtype)


def _swiglu(h, w_gate, w_up, w_down):
    return (jax.nn.silu(h @ w_gate) * (h @ w_up)) @ w_down


def _rotary(t, positions):
    d = t.shape[-1]
    freqs = 1.0 / (ROPE_BASE ** (jnp.arange(0, d, 2, dtype=jnp.float32) / d))
    ang = positions.astype(jnp.float32)[..., None] * freqs
    cos = jnp.cos(ang)[:, :, None, :]
    sin = jnp.sin(ang)[:, :, None, :]
    tf = t.astype(jnp.float32)
    t1, t2 = tf[..., : d // 2], tf[..., d // 2:]
    return jnp.concatenate([t1 * cos - t2 * sin, t1 * sin + t2 * cos], axis=-1)


def _retention_one_direction(q, k, v, log_gamma, include_diag):
    b, h, s, d = q.shape
    n_chunks = s // CHUNK

    def to_chunks(t):
        return t.reshape(b, h, n_chunks, CHUNK, t.shape[-1]).transpose(2, 0, 1, 3, 4)

    idx = jnp.arange(CHUNK, dtype=jnp.float32)
    rel = idx[:, None] - idx[None, :]
    mask = (rel >= 0) if include_diag else (rel > 0)
    lg = log_gamma[:, None, None]
    intra_decay = jnp.where(mask[None], jnp.exp(jnp.where(mask[None], rel[None], 0.0) * lg), 0.0)
    q_decay = jnp.exp((idx + 1.0)[None, :] * log_gamma[:, None])[..., None]
    k_decay = jnp.exp((CHUNK - 1.0 - idx)[None, :] * log_gamma[:, None])[..., None]
    chunk_decay = jnp.exp(CHUNK * log_gamma)[:, None, None]

    def step(state, qkv):
        qc, kc, vc = qkv
        scores = jnp.einsum('bhid,bhjd->bhij', qc, kc) * intra_decay
        inner = jnp.einsum('bhij,bhje->bhie', scores, vc)
        cross = jnp.einsum('bhid,bhde->bhie', qc * q_decay, state)
        state = state * chunk_decay + jnp.einsum('bhjd,bhje->bhde', kc * k_decay, vc)
        return state, inner + cross

    state0 = jnp.zeros((b, h, d, v.shape[-1]), jnp.float32)
    _, out = lax.scan(step, state0, (to_chunks(q), to_chunks(k), to_chunks(v)))
    return out.transpose(1, 2, 0, 3, 4).reshape(b, h, s, v.shape[-1])


def _bidirectional_retention(q, k, v, logit_fwd, logit_bwd):
    lg_f = jax.nn.log_sigmoid(logit_fwd.astype(jnp.float32))
    lg_b = jax.nn.log_sigmoid(logit_bwd.astype(jnp.float32))
    out_f = _retention_one_direction(q, k, v, lg_f, True)
    flip = lambda t: t[:, :, ::-1]
    out_b = flip(_retention_one_direction(flip(q), flip(k), flip(v), lg_b, False))
    return out_f + out_b


def _centred_mean_minus_self(p, window):
    b, s, c = p.shape
    cs = jnp.concatenate([jnp.zeros((b, 1, c), p.dtype), jnp.cumsum(p, axis=1)], axis=1)
    lo = window // 2
    hi = window - 1 - lo
    n = jnp.arange(s)
    start = jnp.clip(n - lo, 0, s)
    end = jnp.clip(n + hi + 1, 0, s)
    total = cs[:, end] - cs[:, start]
    count = (end - start).astype(p.dtype)
    return total / count[None, :, None] - p


def setup_inputs(seed: int = 0) -> dict:
    key = jax.random.key(seed)
    ks = jax.random.split(key, 24)
    f32 = jnp.float32

    def nrm(k, shape, fan_in):
        return jax.random.normal(k, shape, f32) * (fan_in ** -0.5)

    def gain(k, shape):
        return 1.0 + 0.02 * jax.random.normal(k, shape, f32)

    hh = jnp.arange(RET_HEADS, dtype=f32)
    gamma = 1.0 - jnp.exp2(-5.0 - hh)
    base_logit = jnp.log(gamma) - jnp.log1p(-gamma)

    x = jax.random.normal(ks[0], (BATCH, SEQ, D_MODEL), f32)
    positions = jnp.broadcast_to(jnp.arange(SEQ, dtype=jnp.int32)[None, :], (BATCH, SEQ))
    return {
        'x': x,
        'positions': positions,
        'ffn1_norm': gain(ks[1], (DEPTH, D_MODEL)),
        'ffn1_w_gate': nrm(ks[2], (DEPTH, D_MODEL, D_FF), D_MODEL),
        'ffn1_w_up': nrm(ks[3], (DEPTH, D_MODEL, D_FF), D_MODEL),
        'ffn1_w_down': nrm(ks[4], (DEPTH, D_FF, D_MODEL), D_FF),
        'mix_norm': gain(ks[5], (DEPTH, D_MODEL)),
        'w_in': nrm(ks[6], (DEPTH, D_MODEL, PROJ_DIM), D_MODEL),
        'ret_decay_fwd': base_logit[None] + 0.1 * jax.random.normal(ks[7], (DEPTH, RET_HEADS), f32),
        'ret_decay_bwd': base_logit[None] + 0.1 * jax.random.normal(ks[8], (DEPTH, RET_HEADS), f32),
        'ret_head_norm': gain(ks[9], (DEPTH, RET_DIM)),
        'pool_w': nrm(ks[10], (DEPTH, POOL_GROUPS, POOL_GROUP_DIM, POOL_GROUP_DIM), POOL_GROUP_DIM),
        'pool_scale': gain(ks[11], (DEPTH, POOL_DIM)),
        'w_out': nrm(ks[12], (DEPTH, MIX_DIM, D_MODEL), MIX_DIM),
        'ffn2_norm': gain(ks[13], (DEPTH, D_MODEL)),
        'ffn2_w_gate': nrm(ks[14], (DEPTH, D_MODEL, D_FF), D_MODEL),
        'ffn2_w_up': nrm(ks[15], (DEPTH, D_MODEL, D_FF), D_MODEL),
        'ffn2_w_down': nrm(ks[16], (DEPTH, D_FF, D_MODEL), D_FF),
        'final_norm': gain(ks[17], (D_MODEL,)),
    }


def reference(x, positions, ffn1_norm, ffn1_w_gate, ffn1_w_up, ffn1_w_down, mix_norm, w_in,
              ret_decay_fwd, ret_decay_bwd, ret_head_norm, pool_w, pool_scale, w_out,
              ffn2_norm, ffn2_w_gate, ffn2_w_up, ffn2_w_down, final_norm):
    b, s, _ = x.shape
    for layer in range(DEPTH):
        x = x + 0.5 * _swiglu(_rmsnorm(x, ffn1_norm[layer]), ffn1_w_gate[layer],
                              ffn1_w_up[layer], ffn1_w_down[layer])

        h = _rmsnorm(x, mix_norm[layer])
        z = h @ w_in[layer]
        q, k, v, g, p = jnp.split(z, [RET_DIM, 2 * RET_DIM, 3 * RET_DIM, 4 * RET_DIM], axis=-1)

        q = _rotary(q.reshape(b, s, RET_HEADS, RET_HEAD_DIM), positions)
        k = _rotary(k.reshape(b, s, RET_HEADS, RET_HEAD_DIM), positions) * (RET_HEAD_DIM ** -0.5)
        v = v.reshape(b, s, RET_HEADS, RET_HEAD_DIM).astype(jnp.float32)
        ret = _bidirectional_retention(q.transpose(0, 2, 1, 3), k.transpose(0, 2, 1, 3),
                                       v.transpose(0, 2, 1, 3),
                                       ret_decay_fwd[layer], ret_decay_bwd[layer])
        ret = ret.transpose(0, 2, 1, 3)
        ret = ret * lax.rsqrt(jnp.mean(ret * ret, axis=-1, keepdims=True) + EPS)
        ret = ret.reshape(b, s, RET_DIM) * ret_head_norm[layer].astype(jnp.float32)
        ret = (ret * jax.nn.silu(g.astype(jnp.float32))).astype(x.dtype)

        pf = p.astype(jnp.float32).reshape(b, s, POOL_GROUPS, POOL_GROUP_DIM)
        pooled = jnp.stack([_centred_mean_minus_self(pf[:, :, gi], w)
                            for gi, w in enumerate(POOL_WINDOWS)], axis=2)
        pool_out = jnp.einsum('bsgc,gcd->bsgd', pooled, pool_w[layer].astype(jnp.float32))
        pool_out = (pool_out.reshape(b, s, POOL_DIM) * pool_scale[layer].astype(jnp.float32)).astype(x.dtype)

        x = x + jnp.concatenate([ret, pool_out], axis=-1) @ w_out[layer]

        x = x + 0.5 * _swiglu(_rmsnorm(x, ffn2_norm[layer]), ffn2_w_gate[layer],
                              ffn2_w_up[layer], ffn2_w_down[layer])
    return _rmsnorm(x, final_norm)
```

```cpp
#include <hip/hip_runtime.h>
#include <cstdio>
#include <cstdint>

namespace pg8 {
#define PG8_LAS __attribute__((address_space(3)))
typedef unsigned short bf16_t;
typedef short bf16x8 __attribute__((ext_vector_type(8)));
typedef float f32x4 __attribute__((ext_vector_type(4)));
typedef unsigned u32x4 __attribute__((ext_vector_type(4)));
constexpr int BM = 256, BK = 64, HALF = 128, HTB = HALF * BK * 2  , STAGE_BYTES = 8 * HTB, NXCD = 8, WGM = 8;

__host__ __device__ __forceinline__ int lds_byte(int r, int c) { const int st = (r >> 4) * 2 + (c >> 5), rr = r & 15, cc = c & 31, ob = rr * 64 + cc * 2; return st * 1024 + (ob ^ (((ob >> 9) & 1) << 5)); }
__host__ __device__ __forceinline__ void stage_rc(int b, int& R, int& C) { const int st = b / 1024, sb = b % 1024, swz = sb ^ (((sb >> 9) & 1) << 5); R = (st >> 1) * 16 + swz / 64; C = (st & 1) * 32 + (swz % 64) / 2; }
__host__ __device__ __forceinline__ int perm32(int rho) { const int n = rho >> 4, i = rho & 15; return 8 * (i >> 2) + 4 * n + (i & 3); }

struct Unit { int pm, pn, z; };
struct Gemm { const bf16_t* A; const bf16_t* Bt; int lda, ldb, K; };

struct SchedGrid {
    int nM, nN, nwg, G, c; size_t astep, bstep;
    __device__ __forceinline__ void init(int nM_, int nN_, int G_, int c_, int lda, int ldb) { nM = nM_; nN = nN_; nwg = nM * nN; G = G_; c = c_; astep = (size_t)BM * lda * 2; bstep = (size_t)BM * ldb * 2; }
    __device__ __forceinline__ bool next(int i, Unit& u) const {
        const long L = (long)i * G + c; if (L >= nwg) return false;
        int wgid = (int)L; { const int q = nwg / NXCD, r = nwg % NXCD, xcd = wgid % NXCD, off = wgid / NXCD; wgid = (xcd < r ? xcd * (q + 1) : r * (q + 1) + (xcd - r) * q) + off; }
        const int nig = WGM * nN, gid = wgid / nig, fm = gid * WGM, gsz = (nM - fm) < WGM ? (nM - fm) : WGM;
        u.pm = fm + ((wgid % nig) % gsz); u.pn = (wgid % nig) / gsz; u.z = 0; return true;
    }
    __device__ __forceinline__ size_t a_off(const Unit& u) const { return (size_t)u.pm * astep; }
    __device__ __forceinline__ size_t b_off(const Unit& u) const { return (size_t)u.pn * bstep; }
};

__device__ __forceinline__ unsigned cvt_pk_bf16(float lo, float hi) { unsigned r; asm volatile("v_cvt_pk_bf16_f32 %0, %1, %2" : "=v"(r) : "v"(lo), "v"(hi)); return r; }

template <class Epi, class Sched>
__device__ __forceinline__ void gemm_phase(PG8_LAS unsigned char* lds, const Gemm g, const Sched& S, const Epi& E) {
    const int tid = threadIdx.x, wid = __builtin_amdgcn_readfirstlane(tid >> 6), lane = tid & 63, wr = wid >> 2, wc = wid & 3, fr = lane & 15, fq = lane >> 4;
    int nt = g.K / BK; asm volatile("" : "+s"(nt));
    unsigned voffA[2], voffB[2];
#pragma unroll
    for (int i = 0; i < 2; ++i) { int R, C; stage_rc(tid * 16 + i * 8192, R, C); const int Rb = (R & ~31) + perm32(R & 31);
        voffA[i] = (unsigned)(R * g.lda + C) * 2u; voffB[i] = (unsigned)(Rb * g.ldb + C) * 2u; }
    const size_t kstep = (size_t)(BK * 2);
    const size_t hstepA = (size_t)HALF * g.lda * 2, hstepB = (size_t)HALF * g.ldb * 2;
    const unsigned ldsw = (unsigned)wid * 1024u;
    const int aoff = lds_byte(wr * 64 + fr, fq * 8), boff = lds_byte(wc * 32 + fr, fq * 8);
#define PG8_SA(b, h) (((b) * 2 + (h)) * HTB)
#define PG8_SB(b, h) ((4 + (b) * 2 + (h)) * HTB)
#define PG8_STAGE(bufoff, gbase, voff) do { _Pragma("unroll") for (int _i = 0; _i < 2; ++_i) \
        __builtin_amdgcn_global_load_lds((const unsigned*)((const char*)(gbase) + (voff)[_i]), (PG8_LAS unsigned*)(lds + (bufoff) + ldsw + _i * 8192), 16, 0, 0); } while (0)
#define PG8_LDA(dst, b, h) do { _Pragma("unroll") for (int m = 0; m < 4; ++m) _Pragma("unroll") for (int k = 0; k < 2; ++k) dst[m][k] = *(const PG8_LAS bf16x8*)(lds + PG8_SA(b, h) + aoff + m * 2048 + k * 1024); } while (0)
#define PG8_LDB(dst, b, h) do { _Pragma("unroll") for (int n = 0; n < 2; ++n) _Pragma("unroll") for (int k = 0; k < 2; ++k) dst[n][k] = *(const PG8_LAS bf16x8*)(lds + PG8_SB(b, h) + boff + n * 2048 + k * 1024); } while (0)
#define PG8_MMA(ai, bj, At, Bt) do { __builtin_amdgcn_s_setprio(1); _Pragma("unroll") for (int m = 0; m < 4; ++m) _Pragma("unroll") for (int n = 0; n < 2; ++n) _Pragma("unroll") for (int k = 0; k < 2; ++k) \
        acc[ai][bj][m][n] = __builtin_amdgcn_mfma_f32_16x16x32_bf16(Bt[n][k], At[m][k], acc[ai][bj][m][n], 0, 0, 0); __builtin_amdgcn_s_setprio(0); } while (0)
#define PG8_WAIT_V(n) asm volatile("s_waitcnt vmcnt(" #n ")" ::: "memory")
#define PG8_WAIT_L(n) asm volatile("s_waitcnt lgkmcnt(" #n ")" ::: "memory")
#define PG8_BAR __builtin_amdgcn_s_barrier()
#define PG8_SCHED __builtin_amdgcn_sched_barrier(0)
    Unit cur, nxt; int ui = 0;
    if (!S.next(0, cur)) return;
    f32x4 acc[2][2][4][2];
#pragma unroll
    for (int a = 0; a < 2; ++a)
#pragma unroll
        for (int b = 0; b < 2; ++b)
#pragma unroll
            for (int m = 0; m < 4; ++m)
#pragma unroll
                for (int n = 0; n < 2; ++n) acc[a][b][m][n] = (f32x4){0.f, 0.f, 0.f, 0.f};
    bf16x8 At[4][2], B0[2][2], B1[2][2];
    const char* cA = (const char*)g.A + S.a_off(cur); const char* cB = (const char*)g.Bt + S.b_off(cur);
    PG8_STAGE(PG8_SB(0, 0), cB, voffB); PG8_STAGE(PG8_SB(0, 1), cB + hstepB, voffB); PG8_STAGE(PG8_SA(0, 0), cA, voffA); PG8_STAGE(PG8_SA(0, 1), cA + hstepA, voffA);
    if (wr == 1) PG8_BAR;
    PG8_WAIT_V(2); PG8_BAR;
    PG8_STAGE(PG8_SB(1, 0), cB + kstep, voffB); PG8_STAGE(PG8_SA(1, 0), cA + kstep, voffA); PG8_STAGE(PG8_SB(1, 1), cB + hstepB + kstep, voffB);
    PG8_WAIT_V(6); PG8_BAR;
    for (;;) {
        const bool has_next = S.next(ui + 1, nxt);
        const char* nA = has_next ? (const char*)g.A + S.a_off(nxt) : cA; const char* nB = has_next ? (const char*)g.Bt + S.b_off(nxt) : cB;
        for (int t = 0; t < nt; t += 2) {
            const bool last = (t == nt - 2);
            const char* a1 = cA + (size_t)(t + 1) * kstep;
            const char* a2 = last ? nA : cA + (size_t)(t + 2) * kstep; const char* b2 = last ? nB : cB + (size_t)(t + 2) * kstep;
            const char* a3 = a2 + kstep; const char* b3 = b2 + kstep;
            PG8_LDB(B0, 0, 0); PG8_LDB(B1, 0, 1); PG8_SCHED; PG8_LDA(At, 0, 0); PG8_STAGE(PG8_SA(1, 1), a1 + hstepA, voffA);
            PG8_WAIT_V(8); PG8_WAIT_L(0); PG8_BAR; PG8_MMA(0, 0, At, B0); PG8_MMA(0, 1, At, B1); PG8_BAR; PG8_SCHED;
            PG8_LDA(At, 0, 1); PG8_STAGE(PG8_SB(0, 0), b2, voffB); PG8_STAGE(PG8_SB(0, 1), b2 + hstepB, voffB); PG8_STAGE(PG8_SA(0, 0), a2, voffA);
            PG8_WAIT_V(8); PG8_WAIT_L(0); PG8_BAR; PG8_MMA(1, 0, At, B0); PG8_MMA(1, 1, At, B1); PG8_BAR; PG8_SCHED;
            PG8_LDB(B0, 1, 0); PG8_LDB(B1, 1, 1); PG8_SCHED; PG8_LDA(At, 1, 0); PG8_STAGE(PG8_SA(0, 1), a2 + hstepA, voffA);
            PG8_WAIT_V(8); PG8_WAIT_L(0); PG8_BAR; PG8_MMA(0, 0, At, B0); PG8_MMA(0, 1, At, B1); PG8_BAR; PG8_SCHED;
            PG8_LDA(At, 1, 1); PG8_STAGE(PG8_SB(1, 0), b3, voffB); PG8_STAGE(PG8_SB(1, 1), b3 + hstepB, voffB); PG8_STAGE(PG8_SA(1, 0), a3, voffA);
            PG8_WAIT_V(8); PG8_WAIT_L(0); PG8_BAR; PG8_MMA(1, 0, At, B0); PG8_MMA(1, 1, At, B1); PG8_BAR; PG8_SCHED;
        }
        if (wr == 0) PG8_BAR;
        { int fr2 = fr, fq2 = fq; asm volatile("" : "+v"(fr2), "+v"(fq2));
          E(acc, cur, wr, wc, fr2, fq2); }
        if (!has_next) break;
#pragma unroll
        for (int a = 0; a < 2; ++a)
#pragma unroll
            for (int b = 0; b < 2; ++b)
#pragma unroll
                for (int m = 0; m < 4; ++m)
#pragma unroll
                    for (int n = 0; n < 2; ++n) acc[a][b][m][n] = (f32x4){0.f, 0.f, 0.f, 0.f};
        cur = nxt; cA = nA; cB = nB; ++ui;
        if (wr == 1) PG8_BAR;
    }
    PG8_WAIT_V(0);
    PG8_BAR;
#undef PG8_SA
#undef PG8_SB
#undef PG8_STAGE
#undef PG8_LDA
#undef PG8_LDB
#undef PG8_MMA
#undef PG8_WAIT_V
#undef PG8_WAIT_L
#undef PG8_BAR
#undef PG8_SCHED
}
}

constexpr int NWAVES = 8;
constexpr int S_ = 16384, DM = 4096, FF = 11008, PROJ = 10240, RD = 2048, NH = 8, HD = 256, CH = 256, NCH = S_ / CH, PD = 2048;
constexpr float EPS = 1e-6f;
constexpr int KCAT = 768;

constexpr size_t MiB = 1u << 20;
constexpr size_t WS_CTL = 0, CTL_ZERO_BYTES = 1 * MiB;
constexpr size_t WS_TAB = 1 * MiB;
constexpr size_t WS_CS = 2 * MiB;
constexpr size_t WS_WPOOL = 18 * MiB;
constexpr size_t WS_WIN = 20 * MiB, WS_WOUT = 100 * MiB, WS_WGU2 = 132 * MiB, WS_WD2 = 304 * MiB;
constexpr size_t WS_XB = 390 * MiB;
constexpr size_t WS_WGU1 = 518 * MiB, WS_WD1 = 690 * MiB, WS_ACT = 776 * MiB;
constexpr size_t WS_QROW = 518 * MiB, WS_KROW = 582 * MiB, WS_KDT = 646 * MiB  , WS_GS = 774 * MiB, WS_PB = 838 * MiB, WS_POOLED = 902 * MiB;
constexpr size_t WS_ACAT = 966 * MiB, WS_BCAT = 1158 * MiB, WS_END = 1350 * MiB;
constexpr size_t WS_X2B = 518 * MiB;
static_assert(WS_WIN + (size_t)PROJ * DM * 2 <= WS_WOUT && WS_WOUT + (size_t)DM * DM * 2 <= WS_WGU2 && WS_WGU2 + (size_t)2 * FF * DM * 2 <= WS_WD2 && WS_WD2 + (size_t)DM * FF * 2 <= WS_XB, "weights map");
static_assert(WS_XB + (size_t)S_ * DM * 2 <= WS_WGU1 && WS_WGU1 + (size_t)2 * FF * DM * 2 <= WS_WD1 && WS_WD1 + (size_t)DM * FF * 2 <= WS_ACT && WS_ACT + (size_t)S_ * FF * 2 <= WS_END, "ffn map");
static_assert(WS_ACAT + (size_t)NH * S_ * KCAT * 2 <= WS_BCAT && WS_BCAT + (size_t)NH * NCH * HD * KCAT * 2 <= WS_END && WS_POOLED + (size_t)S_ * PD * 2 <= WS_ACAT, "mixer map");
constexpr int CW_BAR = 4096;
constexpr int CW_RSQ = 16384;

constexpr int RING_OFF = 0, RING_BYTES = 131072;
constexpr int LDS_BYTES = 147456;
constexpr int EPI_SCR_OFF = 135168;
constexpr int MISC_OFF = LDS_BYTES - 256;
constexpr int TR_LD = 65, TR_BYTES = 64 * TR_LD * 4;
static_assert(NWAVES * TR_BYTES <= EPI_SCR_OFF + 4096 && EPI_SCR_OFF + 4096 <= MISC_OFF, "LDS map");

#define GAS __attribute__((address_space(1)))
#define LAS __attribute__((address_space(3)))
typedef unsigned short bf16;
typedef unsigned v4u __attribute__((ext_vector_type(4)));
typedef unsigned v2u __attribute__((ext_vector_type(2)));
typedef float f32x4 __attribute__((ext_vector_type(4)));
typedef GAS unsigned gu32;
#define RLX_AGENT __ATOMIC_RELAXED, __HIP_MEMORY_SCOPE_AGENT
#define LDS_WAIT() asm volatile("s_waitcnt lgkmcnt(0)" ::: "memory")
#define VM_WAIT() asm volatile("s_waitcnt vmcnt(0)" ::: "memory")
__device__ __forceinline__ unsigned f2bf(float f) { unsigned u = __builtin_bit_cast(unsigned, f); return (u + 0x7fffu + ((u >> 16) & 1u)) >> 16; }
__device__ __forceinline__ unsigned pk2(float lo, float hi) { return pg8::cvt_pk_bf16(lo, hi); }
__device__ __forceinline__ float bf2f(unsigned h) { return __builtin_bit_cast(float, h << 16); }
__device__ __forceinline__ float fast_exp2(float x) { return __builtin_amdgcn_exp2f(x); }
__device__ __forceinline__ float silu_f(float x) { return x * __builtin_amdgcn_rcpf(1.0f + fast_exp2(-1.4426950408889634f * x)); }
__device__ __forceinline__ float log2_sigmoid(float x) { return -log1pf(expf(-x)) * 1.4426950408889634f; }

#define XB_TMO      128
#define XB_XCNT(j)  (256  + 64 * (j))
#define XB_XSUB(j)  (1280 + 64 * (j))
#define XB_XGEN(j)  (2304 + 64 * (j))
#define XB_TOP      3328
#define XB_TOPGEN   3392
#define XCD_BAR_WORDS 3456
#define XB_SPIN_CAP (1u << 18)

__device__ __forceinline__ unsigned xb_ld(unsigned* p)              { return __hip_atomic_load(p, __ATOMIC_RELAXED, __HIP_MEMORY_SCOPE_AGENT); }
__device__ __forceinline__ unsigned xb_add(unsigned* p, unsigned v) { return __hip_atomic_fetch_add(p, v, __ATOMIC_RELAXED, __HIP_MEMORY_SCOPE_AGENT); }
__device__ __forceinline__ unsigned xb_xcc_id() { return (unsigned)__builtin_amdgcn_s_getreg((3 << 11) | 20) & 0xFu; }
#define XB_SPIN(cond, bar) do { unsigned _sp = 0; while (cond) { __builtin_amdgcn_s_sleep(1); \
    if ((++_sp & 255u) == 0u) { if (xb_ld(&(bar)[XB_TMO])) break; if (_sp > XB_SPIN_CAP) { atomicAdd(&(bar)[XB_TMO], 1u); break; } } } } while (0)

struct XcdBarrier {
    unsigned* bar; unsigned x;
    volatile LAS unsigned* st;
};
__device__ __forceinline__ XcdBarrier xcd_barrier_post(unsigned* bar, volatile LAS unsigned* st) {
    XcdBarrier b; b.bar = bar; b.x = xb_xcc_id(); b.st = st;
    if (threadIdx.x == 0) (void)xb_add(&bar[XB_XCNT(b.x)], 1u);
    return b;
}
__device__ __forceinline__ void xcd_barrier_complete(unsigned* bar, unsigned x, unsigned& nloc, unsigned& nx) {
    const unsigned G = gridDim.x * gridDim.y * gridDim.z;
    unsigned sum, cnt, mine, sp = 0u;
    for (;;) {
        sum = 0u; cnt = 0u; mine = 0u;
#pragma unroll
        for (unsigned j = 0; j < 16; ++j) { const unsigned c = xb_ld(&bar[XB_XCNT(j)]); sum += c; cnt += (c > 0u) ? 1u : 0u; mine = (j == x) ? c : mine; }
        if (sum == G) break;
        __builtin_amdgcn_s_sleep(1);
        if ((++sp & 255u) == 0u) { if (xb_ld(&bar[XB_TMO])) break; if (sp > XB_SPIN_CAP) { atomicAdd(&bar[XB_TMO], 1u); break; } }
    }
    nloc = mine > 0u ? mine : 1u; nx = cnt > 0u ? cnt : 1u;
}
__device__ __forceinline__ void xcd_barrier(const XcdBarrier& b) {
    asm volatile("s_waitcnt vmcnt(0)" ::: "memory");
    __syncthreads();
    if (threadIdx.x == 0) {
        unsigned* bar = b.bar;
        __builtin_amdgcn_s_waitcnt(0);
        unsigned nloc = b.st[0], nx = b.st[1];
        if (nloc == 0u) { xcd_barrier_complete(bar, b.x, nloc, nx); b.st[0] = nloc; b.st[1] = nx; }
        const unsigned old = xb_add(&bar[XB_XSUB(b.x)], 1u);
        const unsigned gen = old / nloc;
        if (old + 1u == (gen + 1u) * nloc) {
            __builtin_amdgcn_fence(__ATOMIC_RELEASE, "agent");
            asm volatile("s_waitcnt vmcnt(0)" ::: "memory");
            const unsigned og = xb_add(&bar[XB_TOP], 1u);
            const unsigned tg = og / nx;
            if (og + 1u == (tg + 1u) * nx) xb_add(&bar[XB_TOPGEN], 1u);
            else XB_SPIN(xb_ld(&bar[XB_TOPGEN]) == tg, bar);
            __builtin_amdgcn_fence(__ATOMIC_ACQUIRE, "agent");
            xb_add(&bar[XB_XGEN(b.x)], 1u);
            asm volatile("s_waitcnt vmcnt(0)" ::: "memory");
        } else {
            XB_SPIN(xb_ld(&bar[XB_XGEN(b.x)]) == gen, bar);
            __builtin_amdgcn_fence(__ATOMIC_ACQUIRE, "agent");
            asm volatile("s_waitcnt vmcnt(0)" ::: "memory");
        }
    }
    __syncthreads();
}

using pg8::Unit;
typedef pg8::f32x4 accv;

__device__ __forceinline__ v4u pack8(const accv& v0, const accv& v1) { v4u w; w.x = pk2(v0[0], v0[1]); w.y = pk2(v0[2], v0[3]); w.z = pk2(v1[0], v1[1]); w.w = pk2(v1[2], v1[3]); return w; }

struct EpiGateUp {
    static constexpr bool PERM = true;
    const float* rowsq; bf16* act;
    __device__ __forceinline__ void operator()(const accv (&acc)[2][2][4][2], const Unit& u, int wr, int wc, int fr, int fq) const {
        const int row0 = u.pm * 256 + wr * 64 + fr, col0 = u.pn * 128 + wc * 32 + 8 * fq;
#pragma unroll
        for (int ai = 0; ai < 2; ++ai)
#pragma unroll
            for (int m = 0; m < 4; ++m) { const int row = row0 + ai * 128 + m * 16; const float rs = 1.0f / sqrtf(rowsq[row] * (1.0f / DM) + EPS);
                accv o[2];
#pragma unroll
                for (int n = 0; n < 2; ++n)
#pragma unroll
                    for (int j = 0; j < 4; ++j) { const float g = acc[ai][0][m][n][j] * rs, up = acc[ai][1][m][n][j] * rs; o[n][j] = silu_f(g) * up; }
                *(v4u*)(act + (size_t)row * FF + col0) = pack8(o[0], o[1]); }
    }
};

struct EpiResid {
    static constexpr bool PERM = true;
    const float* xold; float* xnew; bf16* xb; float* rowsq; float scale;
    __device__ __forceinline__ void operator()(const accv (&acc)[2][2][4][2], const Unit& u, int wr, int wc, int fr, int fq) const {
        const int row0 = u.pm * 256 + wr * 64 + fr, col0 = u.pn * 256 + wc * 32 + 8 * fq;
#pragma unroll
        for (int ai = 0; ai < 2; ++ai)
#pragma unroll
            for (int m = 0; m < 4; ++m) { const int row = row0 + ai * 128 + m * 16; const size_t off = (size_t)row * DM + col0; float ss = 0.f;
#pragma unroll
                for (int bj = 0; bj < 2; ++bj) { accv v[2];
#pragma unroll
                    for (int n = 0; n < 2; ++n) { const accv xo = *(const accv*)(xold + off + bj * 128 + 4 * n); v[n] = xo + acc[ai][bj][m][n] * scale;
                        *(accv*)(xnew + off + bj * 128 + 4 * n) = v[n]; ss += (v[n][0] * v[n][0] + v[n][1] * v[n][1]) + (v[n][2] * v[n][2] + v[n][3] * v[n][3]); }
                    if (xb) *(v4u*)(xb + off + bj * 128) = pack8(v[0], v[1]); }
                ss += __shfl_xor(ss, 16); ss += __shfl_xor(ss, 32);
                if (fq == 0) atomicAdd(rowsq + row, ss);
                asm volatile("" ::: "memory"); }
    }
};

struct EpiZ {
    static constexpr bool PERM = true;
    const float* rowsq; const float* cs; const float* l2tab;
    bf16 *qrow, *krow, *kdt, *gs, *pb, *acat, *bcat;
    __device__ __forceinline__ void operator()(const accv (&acc)[2][2][4][2], const Unit& u, int wr, int wc, int fr, int fq) const {
        const int type = u.pn >> 3, h = u.pn & 7, c = u.pm;
        const int i0 = wr * 64 + fr, d1 = wc * 32 + 8 * fq;
        if (type <= 1) {
            const float l2a = l2tab[h], l2b = l2tab[8 + h];
#pragma unroll
            for (int ai = 0; ai < 2; ++ai)
#pragma unroll
                for (int m = 0; m < 4; ++m) { const int i = i0 + ai * 128 + m * 16, s = c * 256 + i;
                    const float rs = 1.0f / sqrtf(rowsq[s] * (1.0f / DM) + EPS);
                    const accv c0 = *(const accv*)(cs + (size_t)s * 128 + d1), c1 = *(const accv*)(cs + (size_t)s * 128 + d1 + 4);
                    const accv s0 = *(const accv*)(cs + (size_t)S_ * 128 + (size_t)s * 128 + d1), s1 = *(const accv*)(cs + (size_t)S_ * 128 + (size_t)s * 128 + d1 + 4);
                    accv r1[2], r2[2];
                    r1[0] = acc[ai][0][m][0] * c0 - acc[ai][1][m][0] * s0; r1[1] = acc[ai][0][m][1] * c1 - acc[ai][1][m][1] * s1;
                    r2[0] = acc[ai][0][m][0] * s0 + acc[ai][1][m][0] * c0; r2[1] = acc[ai][0][m][1] * s1 + acc[ai][1][m][1] * c1;
                    if (type == 0) {
                        const size_t o = (size_t)s * RD + h * 256 + d1;
                        *(v4u*)(qrow + o) = pack8(r1[0] * rs, r1[1] * rs); *(v4u*)(qrow + o + 128) = pack8(r2[0] * rs, r2[1] * rs);
                        const float sf = rs * fast_exp2(l2a * (float)(i + 1)), sb = rs * fast_exp2(l2b * (float)(CH - i));
                        const size_t oa = ((size_t)h * S_ + s) * KCAT + 256 + d1;
                        *(v4u*)(acat + oa) = pack8(r1[0] * sf, r1[1] * sf); *(v4u*)(acat + oa + 128) = pack8(r2[0] * sf, r2[1] * sf);
                        *(v4u*)(acat + oa + 256) = pack8(r1[0] * sb, r1[1] * sb); *(v4u*)(acat + oa + 384) = pack8(r2[0] * sb, r2[1] * sb);
                    } else {
                        const float rk = rs * 0.0625f;
                        const size_t o = (size_t)s * RD + h * 256 + d1;
                        *(v4u*)(krow + o) = pack8(r1[0] * rk, r1[1] * rk); *(v4u*)(krow + o + 128) = pack8(r2[0] * rk, r2[1] * rk);
                        const float sf = rk * fast_exp2(l2a * (float)(CH - 1 - i)), sb = rk * fast_exp2(l2b * (float)i);
                        bf16* tf = kdt + ((size_t)h * 256 + d1) * S_ + s; bf16* tb = tf + (size_t)RD * S_;
#pragma unroll
                        for (int n = 0; n < 2; ++n)
#pragma unroll
                            for (int j = 0; j < 4; ++j) { const size_t t = (size_t)(4 * n + j) * S_;
                                tf[t] = (bf16)f2bf(r1[n][j] * sf); tf[t + (size_t)128 * S_] = (bf16)f2bf(r2[n][j] * sf);
                                tb[t] = (bf16)f2bf(r1[n][j] * sb); tb[t + (size_t)128 * S_] = (bf16)f2bf(r2[n][j] * sb); }
                    }
                    asm volatile("" ::: "memory"); }
        } else if (type == 2) {
            bf16* base = bcat + ((size_t)(h * NCH + c) * 256) * KCAT;
#pragma unroll
            for (int ai = 0; ai < 2; ++ai)
#pragma unroll
                for (int m = 0; m < 4; ++m) { const int i = i0 + ai * 128 + m * 16, s = c * 256 + i;
                    const float rs = 1.0f / sqrtf(rowsq[s] * (1.0f / DM) + EPS);
#pragma unroll
                    for (int bj = 0; bj < 2; ++bj)
#pragma unroll
                        for (int n = 0; n < 2; ++n)
#pragma unroll
                            for (int j = 0; j < 4; ++j) base[(size_t)(bj * 128 + d1 + 4 * n + j) * KCAT + i] = (bf16)f2bf(acc[ai][bj][m][n][j] * rs); }
        } else {
            bf16* dst = (type == 3) ? gs : pb;
#pragma unroll
            for (int ai = 0; ai < 2; ++ai)
#pragma unroll
                for (int m = 0; m < 4; ++m) { const int i = i0 + ai * 128 + m * 16, s = c * 256 + i;
                    const float rs = 1.0f / sqrtf(rowsq[s] * (1.0f / DM) + EPS);
#pragma unroll
                    for (int bj = 0; bj < 2; ++bj) { accv v0 = acc[ai][bj][m][0] * rs, v1 = acc[ai][bj][m][1] * rs;
                        if (type == 3) {
#pragma unroll
                            for (int j = 0; j < 4; ++j) { v0[j] = silu_f(v0[j]); v1[j] = silu_f(v1[j]); } }
                        *(v4u*)(dst + (size_t)s * RD + h * 256 + bj * 128 + d1) = pack8(v0, v1); } }
        }
    }
};

struct EpiKV {
    static constexpr bool PERM = true;
    bf16* bcat;
    __device__ __forceinline__ void operator()(const accv (&acc)[2][2][4][2], const Unit& u, int wr, int wc, int fr, int fq) const {
        bf16* base = bcat + ((size_t)(u.pn * NCH + u.pm) * 256) * KCAT + 256 + 256 * u.z + wc * 32 + 8 * fq;
        const int r0 = wr * 64 + fr;
#pragma unroll
        for (int ai = 0; ai < 2; ++ai)
#pragma unroll
            for (int m = 0; m < 4; ++m) { bf16* rp = base + (size_t)(r0 + ai * 128 + m * 16) * KCAT;
#pragma unroll
                for (int bj = 0; bj < 2; ++bj) *(v4u*)(rp + bj * 128) = pack8(acc[ai][bj][m][0], acc[ai][bj][m][1]); }
    }
};

struct EpiS {
    static constexpr bool PERM = true;
    const float* l2tab; bf16* acat;
    __device__ __forceinline__ void operator()(const accv (&acc)[2][2][4][2], const Unit& u, int wr, int wc, int fr, int fq) const {
        const int h = u.pn, c = u.pm;
        float l2a = l2tab[h], l2b = l2tab[8 + h];
        const int i0 = wr * 64 + fr, j0 = wc * 32 + 8 * fq;
        bf16* base = acat + ((size_t)h * S_ + (size_t)c * 256) * KCAT + j0;
#pragma unroll
        for (int ai = 0; ai < 2; ++ai)
#pragma unroll
            for (int m = 0; m < 4; ++m) { const int i = i0 + ai * 128 + m * 16;
#pragma unroll
                for (int bj = 0; bj < 2; ++bj) { accv v[2];
#pragma unroll
                    for (int n = 0; n < 2; ++n)
#pragma unroll
                        for (int j = 0; j < 4; ++j) { const float dd = (float)(i - (bj * 128 + j0 + 4 * n + j)); const float e = l2a * fmaxf(dd, 0.f) - l2b * fminf(dd, 0.f); v[n][j] = acc[ai][bj][m][n][j] * fast_exp2(e); }
                    *(v4u*)(base + (size_t)i * KCAT + bj * 128) = pack8(v[0], v[1]); }
                asm volatile("" : "+v"(l2a), "+v"(l2b) :: "memory"); }
    }
};

struct EpiPool {
    static constexpr bool PERM = true;
    const float* pscale; bf16* mix;
    __device__ __forceinline__ void operator()(const accv (&acc)[2][2][4][2], const Unit& u, int wr, int wc, int fr, int fq) const {
        const int row0 = u.pm * 256 + wr * 64 + fr, colp = u.pn * 256 + wc * 32 + 8 * fq;
        accv sc[2][2];
#pragma unroll
        for (int bj = 0; bj < 2; ++bj)
#pragma unroll
            for (int n = 0; n < 2; ++n) sc[bj][n] = *(const accv*)(pscale + colp + bj * 128 + 4 * n);
#pragma unroll
        for (int ai = 0; ai < 2; ++ai)
#pragma unroll
            for (int m = 0; m < 4; ++m) { bf16* rp = mix + (size_t)(row0 + ai * 128 + m * 16) * DM + RD + colp;
#pragma unroll
                for (int bj = 0; bj < 2; ++bj) *(v4u*)(rp + bj * 128) = pack8(acc[ai][bj][m][0] * sc[bj][0], acc[ai][bj][m][1] * sc[bj][1]); }
    }
};

struct EpiOut {
    static constexpr bool PERM = true;
    const float* hnorm; const bf16* gs; bf16* mix; LAS float* scr;
    __device__ __forceinline__ void operator()(const accv (&acc)[2][2][4][2], const Unit& u, int wr, int wc, int fr, int fq) const {
        const int h = u.pn, c = u.pm; const int i0 = wr * 64 + fr, e0 = wc * 32 + 8 * fq;
#pragma unroll
        for (int ai = 0; ai < 2; ++ai)
#pragma unroll
            for (int m = 0; m < 4; ++m) { float ss = 0.f;
#pragma unroll
                for (int bj = 0; bj < 2; ++bj)
#pragma unroll
                    for (int n = 0; n < 2; ++n) { const accv x = acc[ai][bj][m][n]; ss += (x[0] * x[0] + x[1] * x[1]) + (x[2] * x[2] + x[3] * x[3]); }
                ss += __shfl_xor(ss, 16); ss += __shfl_xor(ss, 32);
                if (fq == 0) scr[(i0 + ai * 128 + m * 16) * 4 + wc] = ss; }
        asm volatile("s_waitcnt lgkmcnt(0)" ::: "memory"); __builtin_amdgcn_s_barrier(); asm volatile("" ::: "memory");
        accv hn[2][2];
#pragma unroll
        for (int bj = 0; bj < 2; ++bj)
#pragma unroll
            for (int n = 0; n < 2; ++n) hn[bj][n] = *(const accv*)(hnorm + h * 256 + bj * 128 + e0 + 4 * n);
#pragma unroll
        for (int ai = 0; ai < 2; ++ai)
#pragma unroll
            for (int m = 0; m < 4; ++m) { const int i = i0 + ai * 128 + m * 16; const accv p = *(const LAS accv*)(scr + i * 4);
                const float rn = 1.0f / sqrtf(((p[0] + p[1]) + (p[2] + p[3])) * (1.0f / HD) + EPS);
                const size_t o = (size_t)(c * 256 + i) * RD + h * 256 + e0;
#pragma unroll
                for (int bj = 0; bj < 2; ++bj) { const v4u gv = *(const v4u*)(gs + o + bj * 128);
                    accv g0, g1; g0[0] = bf2f(gv.x & 0xffffu); g0[1] = bf2f(gv.x >> 16); g0[2] = bf2f(gv.y & 0xffffu); g0[3] = bf2f(gv.y >> 16);
                    g1[0] = bf2f(gv.z & 0xffffu); g1[1] = bf2f(gv.z >> 16); g1[2] = bf2f(gv.w & 0xffffu); g1[3] = bf2f(gv.w >> 16);
                    *(v4u*)(mix + (size_t)(c * 256 + i) * DM + h * 256 + bj * 128 + e0) = pack8(acc[ai][bj][m][0] * rn * hn[bj][0] * g0, acc[ai][bj][m][1] * rn * hn[bj][1] * g1); } }
        asm volatile("s_waitcnt lgkmcnt(0)" ::: "memory"); __builtin_amdgcn_s_barrier(); asm volatile("" ::: "memory");
    }
};

struct SchedKV {
    int G, c;
    __device__ __forceinline__ bool next(int i, Unit& u) const { const int L = i * G + c; if (L >= NH * NCH * 2) return false; u.z = L & 1; u.pm = (L >> 1) & (NCH - 1); u.pn = L >> 7; return true; }
    __device__ __forceinline__ size_t a_off(const Unit& u) const { return ((size_t)(u.pn * NCH + u.pm) * 256 * KCAT) * 2; }
    __device__ __forceinline__ size_t b_off(const Unit& u) const { return ((size_t)u.z * RD * S_ + (size_t)u.pn * 256 * S_ + (size_t)u.pm * 256) * 2; }
};
struct SchedS {
    int G, c;
    __device__ __forceinline__ bool next(int i, Unit& u) const { const int L = i * G + c; if (L >= NH * NCH) return false; u.z = 0; u.pm = L & (NCH - 1); u.pn = L >> 6; return true; }
    __device__ __forceinline__ size_t a_off(const Unit& u) const { return ((size_t)u.pm * 256 * RD + (size_t)u.pn * 256) * 2; }
    __device__ __forceinline__ size_t b_off(const Unit& u) const { return a_off(u); }
};
struct SchedPool {
    int G, c;
    __device__ __forceinline__ bool next(int i, Unit& u) const { const int L = i * G + c; if (L >= NCH * 8) return false; u.z = 0; u.pn = L & 7; u.pm = L >> 3; return true; }
    __device__ __forceinline__ size_t a_off(const Unit& u) const { return ((size_t)u.pm * 256 * PD + (size_t)(u.pn >> 1) * 512) * 2; }
    __device__ __forceinline__ size_t b_off(const Unit& u) const { return ((size_t)u.pn * 256 * 512) * 2; }
};
struct SchedOut {
    int G, c;
    __device__ __forceinline__ bool next(int i, Unit& u) const { const int L = i * G + c; if (L >= NH * NCH) return false; u.z = 0; u.pm = L & (NCH - 1); u.pn = L >> 6; return true; }
    __device__ __forceinline__ size_t a_off(const Unit& u) const { return (((size_t)u.pn * S_ + (size_t)u.pm * 256) * KCAT) * 2; }
    __device__ __forceinline__ size_t b_off(const Unit& u) const { return ((size_t)(u.pn * NCH + u.pm) * 256 * KCAT) * 2; }
};

struct Frame {
    LAS unsigned char* lds;
    volatile LAS unsigned* MISC;
    gu32* ctl;
    int tid, lane, wave, G;
};

__device__ __forceinline__ float wave_sum(float v) {
#pragma unroll
    for (int o = 1; o < 64; o <<= 1) v += __shfl_xor(v, o);
    return v;
}

__device__ __forceinline__ void tr_item(const float* __restrict__ W, int K, int N, const float* __restrict__ gain, bf16* WT, int blk, int dblk, int doff, LAS float* scr, int item, int lane) {
    const int nblk = N / 64, kb = item / nblk, nb = item % nblk, k0 = 64 * kb, n0 = 64 * nb;
    const int lr = lane >> 4, lc = (lane & 15) * 4;
    f32x4 v[16];
#pragma unroll
    for (int i = 0; i < 16; ++i) v[i] = *(const f32x4*)(W + (size_t)(k0 + lr + 4 * i) * N + n0 + lc);
#pragma unroll
    for (int i = 0; i < 16; ++i) { const int kk = lr + 4 * i; const float gsc = gain ? gain[k0 + kk] : 1.0f; LAS float* d = scr + kk * TR_LD + lc;
        d[0] = v[i][0] * gsc; d[1] = v[i][1] * gsc; d[2] = v[i][2] * gsc; d[3] = v[i][3] * gsc; }
    LDS_WAIT(); asm volatile("" ::: "memory");
    const int cc = lane & 7;
    const int drow0 = (n0 / blk) * dblk + doff + (n0 % blk);
#pragma unroll
    for (int j = 0; j < 8; ++j) { const int n = (lane >> 3) + 8 * j; const LAS float* s = scr + (8 * cc) * TR_LD + n;
        v4u o; o.x = pk2(s[0 * TR_LD], s[1 * TR_LD]); o.y = pk2(s[2 * TR_LD], s[3 * TR_LD]); o.z = pk2(s[4 * TR_LD], s[5 * TR_LD]); o.w = pk2(s[6 * TR_LD], s[7 * TR_LD]);
        *(v4u*)(WT + (size_t)(drow0 + n) * K + k0 + 8 * cc) = o; }
    LDS_WAIT(); asm volatile("" ::: "memory");
}
__device__ __forceinline__ void tr_matrix(Frame& F, const float* W, int K, int N, const float* gain, bf16* WT, int blk, int dblk, int doff) {
    LAS float* scr = (LAS float*)(F.lds + F.wave * TR_BYTES);
    const int gw = blockIdx.x * NWAVES + F.wave, NGW = F.G * NWAVES, nitems = (K / 64) * (N / 64);
    for (int it = gw; it < nitems; it += NGW) tr_item(W, K, N, gain, WT, blk, dblk, doff, scr, it, F.lane);
}

struct Args { const float* in[19]; const int* pos; float* out; unsigned char* ws; int ph_lo, ph_hi; };
static_assert(sizeof(Args) == 19 * 8 + 8 + 8 + 8 + 8, "Args has no padding");

enum { IN_X = 0, IN_POS = 1, IN_F1N = 2, IN_F1G = 3, IN_F1U = 4, IN_F1D = 5, IN_MIXN = 6, IN_WIN = 7, IN_DECF = 8, IN_DECB = 9, IN_HNORM = 10, IN_POOLW = 11, IN_PSCALE = 12,
       IN_WOUT = 13, IN_F2N = 14, IN_F2G = 15, IN_F2U = 16, IN_F2D = 17, IN_FINN = 18 };
constexpr int NPHASE = 11;
#ifndef MK_PHASE_MASK
#define MK_PHASE_MASK 0x7ff
#endif

__global__ void __launch_bounds__(NWAVES * 64, 2) fwd_kernel(Args args) {
    extern __shared__ __attribute__((aligned(16))) unsigned char lds[];
    Frame F;
    F.lds = (LAS unsigned char*)lds;
    F.MISC = (volatile LAS unsigned*)(F.lds + MISC_OFF);
    F.tid = threadIdx.x; F.lane = F.tid & 63; F.wave = __builtin_amdgcn_readfirstlane(F.tid >> 6);
    F.G = gridDim.x;
    unsigned char* ws = args.ws;
    F.ctl = (gu32*)(ws + WS_CTL);
    if (F.tid < 64) F.MISC[F.tid] = 0u;
    __syncthreads();
    XcdBarrier bar = xcd_barrier_post((unsigned*)(F.ctl + CW_BAR), F.MISC + 8);
    const int lo = args.ph_lo, hi = args.ph_hi;
#define IN(k) (lo <= (k) && (k) < hi)
#define PHON(k) (((MK_PHASE_MASK) >> (k)) & 1)
#define SEAM(k) do { if (IN(k) && IN((k) + 1)) xcd_barrier(bar); } while (0)
    float* rsq = (float*)(ws + WS_CTL) + CW_RSQ;
    const float* x = args.in[IN_X]; float* xres = args.out;
    bf16* xb = (bf16*)(ws + WS_XB);
    const int gw = blockIdx.x * NWAVES + F.wave, NGW = F.G * NWAVES;
    const int gt = blockIdx.x * (NWAVES * 64) + F.tid, NGT = F.G * NWAVES * 64;

    if (PHON(0) && IN(0)) {
        tr_matrix(F, args.in[IN_F1G], DM, FF, args.in[IN_F1N], (bf16*)(ws + WS_WGU1), 128, 256, 0);
        tr_matrix(F, args.in[IN_F1U], DM, FF, args.in[IN_F1N], (bf16*)(ws + WS_WGU1), 128, 256, 128);
        tr_matrix(F, args.in[IN_F1D], FF, DM, nullptr, (bf16*)(ws + WS_WD1), DM, 0, 0);
        tr_matrix(F, args.in[IN_WIN], DM, PROJ, args.in[IN_MIXN], (bf16*)(ws + WS_WIN), PROJ, 0, 0);
        tr_matrix(F, args.in[IN_WOUT], DM, DM, nullptr, (bf16*)(ws + WS_WOUT), DM, 0, 0);
        tr_matrix(F, args.in[IN_F2G], DM, FF, args.in[IN_F2N], (bf16*)(ws + WS_WGU2), 128, 256, 0);
        tr_matrix(F, args.in[IN_F2U], DM, FF, args.in[IN_F2N], (bf16*)(ws + WS_WGU2), 128, 256, 128);
        tr_matrix(F, args.in[IN_F2D], FF, DM, nullptr, (bf16*)(ws + WS_WD2), DM, 0, 0);
#pragma unroll 1
        for (int g = 0; g < 4; ++g) tr_matrix(F, args.in[IN_POOLW] + (size_t)g * 512 * 512, 512, 512, nullptr, (bf16*)(ws + WS_WPOOL) + (size_t)g * 512 * 512, 512, 0, 0);
        for (int m = gw; m < S_; m += NGW) {
            const f32x4* xr = (const f32x4*)(x + (size_t)m * DM) + F.lane; float ss = 0.f;
#pragma unroll
            for (int j = 0; j < 16; j += 2) { const f32x4 a = xr[64 * j], b = xr[64 * (j + 1)];
                ss += (a[0] * a[0] + a[1] * a[1]) + (a[2] * a[2] + a[3] * a[3]) + (b[0] * b[0] + b[1] * b[1]) + (b[2] * b[2] + b[3] * b[3]);
                v2u pa, pbv; pa.x = pk2(a[0], a[1]); pa.y = pk2(a[2], a[3]); pbv.x = pk2(b[0], b[1]); pbv.y = pk2(b[2], b[3]);
                *((v2u*)(xb + (size_t)m * DM) + F.lane + 64 * j) = pa; *((v2u*)(xb + (size_t)m * DM) + F.lane + 64 * (j + 1)) = pbv; }
            ss = wave_sum(ss);
            if (F.lane == 0) rsq[m] = ss;
        }
        if (gt < 16) ((float*)(ws + WS_TAB))[gt] = log2_sigmoid((gt < 8 ? args.in[IN_DECF] : args.in[IN_DECB])[gt & 7]);
        float* cst = (float*)(ws + WS_CS);
        for (int t = gt; t < S_ * 128; t += NGT) { const int s = t >> 7, i = t & 127;
            const float pw = (float)pow(10000.0, (double)((float)i * (1.0f / 128.0f))); const float fr = 1.0f / pw;
            const float ang = (float)args.pos[s] * fr;
            const double rev = (double)ang * 0.15915494309189533577; const float fr_rev = (float)(rev - rint(rev));
            cst[t] = __builtin_amdgcn_cosf(fr_rev); cst[(size_t)S_ * 128 + t] = __builtin_amdgcn_sinf(fr_rev); }
    }
    SEAM(0);

    if (PHON(1) && IN(1)) {
        pg8::Gemm g{xb, (const bf16*)(ws + WS_WGU1), DM, DM, DM}; pg8::SchedGrid S; S.init(S_ / 256, 2 * FF / 256, F.G, (int)blockIdx.x, DM, DM);
        EpiGateUp E{rsq, (bf16*)(ws + WS_ACT)};
        pg8::gemm_phase(F.lds + RING_OFF, g, S, E);
    }
    SEAM(1);
    if (PHON(2) && IN(2)) {
        pg8::Gemm g{(const bf16*)(ws + WS_ACT), (const bf16*)(ws + WS_WD1), FF, FF, FF}; pg8::SchedGrid S; S.init(S_ / 256, DM / 256, F.G, (int)blockIdx.x, FF, FF);
        EpiResid E{x, xres, xb, rsq + S_, 0.5f};
        pg8::gemm_phase(F.lds + RING_OFF, g, S, E);
    }
    SEAM(2);
    if (PHON(3) && IN(3)) {
        pg8::Gemm g{xb, (const bf16*)(ws + WS_WIN), DM, DM, DM}; pg8::SchedGrid S; S.init(S_ / 256, PROJ / 256, F.G, (int)blockIdx.x, DM, DM);
        EpiZ E{rsq + S_, (const float*)(ws + WS_CS), (const float*)(ws + WS_TAB), (bf16*)(ws + WS_QROW), (bf16*)(ws + WS_KROW), (bf16*)(ws + WS_KDT), (bf16*)(ws + WS_GS), (bf16*)(ws + WS_PB),
               (bf16*)(ws + WS_ACAT), (bf16*)(ws + WS_BCAT)};
        pg8::gemm_phase(F.lds + RING_OFF, g, S, E);
    }
    SEAM(3);
    if (PHON(4) && IN(4)) {
#ifndef NO_P4A
        {   const bf16* pbuf = (const bf16*)(ws + WS_PB); bf16* pooled = (bf16*)(ws + WS_POOLED);
            for (int t = gt; t < S_ * (PD / 8); t += NGT) { const int s = t >> 8, cv = t & 255, grp = cv >> 6; const int w = 2 << grp, wl = w >> 1;
                int st = s - wl; st = st < 0 ? 0 : st; int en = s + (w - 1 - wl) + 1; en = en > S_ ? S_ : en;
                float a[8];
#pragma unroll
                for (int j = 0; j < 8; ++j) a[j] = 0.f;
                for (int r = st; r < en; ++r) { const v4u pv = *(const v4u*)(pbuf + (size_t)r * PD + cv * 8);
                    a[0] += bf2f(pv.x & 0xffffu); a[1] += bf2f(pv.x >> 16); a[2] += bf2f(pv.y & 0xffffu); a[3] += bf2f(pv.y >> 16);
                    a[4] += bf2f(pv.z & 0xffffu); a[5] += bf2f(pv.z >> 16); a[6] += bf2f(pv.w & 0xffffu); a[7] += bf2f(pv.w >> 16); }
                const v4u sv = *(const v4u*)(pbuf + (size_t)s * PD + cv * 8); const float inv = 1.0f / (float)(en - st);
                v4u o; o.x = pk2(a[0] * inv - bf2f(sv.x & 0xffffu), a[1] * inv - bf2f(sv.x >> 16)); o.y = pk2(a[2] * inv - bf2f(sv.y & 0xffffu), a[3] * inv - bf2f(sv.y >> 16));
                o.z = pk2(a[4] * inv - bf2f(sv.z & 0xffffu), a[5] * inv - bf2f(sv.z >> 16)); o.w = pk2(a[6] * inv - bf2f(sv.w & 0xffffu), a[7] * inv - bf2f(sv.w >> 16));
                *(v4u*)(pooled + (size_t)s * PD + cv * 8) = o; }
            VM_WAIT(); __syncthreads();
        }
#endif
#ifndef NO_P4B
        {   pg8::Gemm g{(const bf16*)(ws + WS_BCAT), (const bf16*)(ws + WS_KDT), KCAT, S_, CH}; SchedKV S{F.G, (int)blockIdx.x};
            EpiKV E{(bf16*)(ws + WS_BCAT)};
            pg8::gemm_phase(F.lds + RING_OFF, g, S, E); }
#endif
#ifndef NO_P4C
        {   pg8::Gemm g{(const bf16*)(ws + WS_QROW), (const bf16*)(ws + WS_KROW), RD, RD, HD}; SchedS S{F.G, (int)blockIdx.x};
            EpiS E{(const float*)(ws + WS_TAB), (bf16*)(ws + WS_ACAT)};
            pg8::gemm_phase(F.lds + RING_OFF, g, S, E); }
#endif
    }
    SEAM(4);
    if (PHON(5) && IN(5)) {
        {   bf16* bcat = (bf16*)(ws + WS_BCAT);
            for (int t = gt; t < 2 * NH * HD * (HD / 8); t += NGT) { const int dir = t >> 16, rem = t & 65535, h = rem >> 13, e = (rem >> 5) & 255, dv = rem & 31;
                const float l2 = ((const float*)(ws + WS_TAB))[dir * 8 + h]; const float dC = fast_exp2(l2 * (float)CH);
                bf16* p0 = bcat + ((size_t)(h * NCH) * 256 + e) * KCAT + 256 + 256 * dir + dv * 8; const size_t cstep = (size_t)256 * KCAT;
                float run[8];
#pragma unroll
                for (int j = 0; j < 8; ++j) run[j] = 0.f;
#pragma unroll 1
                for (int cb = 0; cb < NCH; cb += 8) { v4u kv[8];
#pragma unroll
                    for (int q = 0; q < 8; ++q) { const int c = dir ? (NCH - 1 - (cb + q)) : (cb + q); kv[q] = *(const v4u*)(p0 + (size_t)c * cstep); }
#pragma unroll
                    for (int q = 0; q < 8; ++q) { const int c = dir ? (NCH - 1 - (cb + q)) : (cb + q);
                        v4u o; o.x = pk2(run[0], run[1]); o.y = pk2(run[2], run[3]); o.z = pk2(run[4], run[5]); o.w = pk2(run[6], run[7]);
                        *(v4u*)(p0 + (size_t)c * cstep) = o;
                        run[0] = run[0] * dC + bf2f(kv[q].x & 0xffffu); run[1] = run[1] * dC + bf2f(kv[q].x >> 16); run[2] = run[2] * dC + bf2f(kv[q].y & 0xffffu); run[3] = run[3] * dC + bf2f(kv[q].y >> 16);
                        run[4] = run[4] * dC + bf2f(kv[q].z & 0xffffu); run[5] = run[5] * dC + bf2f(kv[q].z >> 16); run[6] = run[6] * dC + bf2f(kv[q].w & 0xffffu); run[7] = run[7] * dC + bf2f(kv[q].w >> 16); } } }
            VM_WAIT(); __syncthreads();
        }
        {   pg8::Gemm g{(const bf16*)(ws + WS_POOLED), (const bf16*)(ws + WS_WPOOL), PD, 512, 512}; SchedPool S{F.G, (int)blockIdx.x};
            EpiPool E{args.in[IN_PSCALE], xb};
            pg8::gemm_phase(F.lds + RING_OFF, g, S, E); }
    }
    SEAM(5);
    if (PHON(6) && IN(6)) {
        pg8::Gemm g{(const bf16*)(ws + WS_ACAT), (const bf16*)(ws + WS_BCAT), KCAT, KCAT, KCAT}; SchedOut S{F.G, (int)blockIdx.x};
        EpiOut E{args.in[IN_HNORM], (const bf16*)(ws + WS_GS), xb, (LAS float*)(F.lds + EPI_SCR_OFF)};
        pg8::gemm_phase(F.lds + RING_OFF, g, S, E);
    }
    SEAM(6);
    if (PHON(7) && IN(7)) {
        pg8::Gemm g{xb, (const bf16*)(ws + WS_WOUT), DM, DM, DM}; pg8::SchedGrid S; S.init(S_ / 256, DM / 256, F.G, (int)blockIdx.x, DM, DM);
        EpiResid E{xres, xres, (bf16*)(ws + WS_X2B), rsq + 2 * S_, 1.0f};
        pg8::gemm_phase(F.lds + RING_OFF, g, S, E);
    }
    SEAM(7);
    if (PHON(8) && IN(8)) {
        pg8::Gemm g{(const bf16*)(ws + WS_X2B), (const bf16*)(ws + WS_WGU2), DM, DM, DM}; pg8::SchedGrid S; S.init(S_ / 256, 2 * FF / 256, F.G, (int)blockIdx.x, DM, DM);
        EpiGateUp E{rsq + 2 * S_, (bf16*)(ws + WS_ACT)};
        pg8::gemm_phase(F.lds + RING_OFF, g, S, E);
    }
    SEAM(8);
    if (PHON(9) && IN(9)) {
        pg8::Gemm g{(const bf16*)(ws + WS_ACT), (const bf16*)(ws + WS_WD2), FF, FF, FF}; pg8::SchedGrid S; S.init(S_ / 256, DM / 256, F.G, (int)blockIdx.x, FF, FF);
        EpiResid E{xres, xres, nullptr, rsq + 3 * S_, 0.5f};
        pg8::gemm_phase(F.lds + RING_OFF, g, S, E);
    }
    SEAM(9);
    if (PHON(10) && IN(10)) {
        const float* fn = args.in[IN_FINN];
        const unsigned tmo = __hip_atomic_load((unsigned*)(F.ctl + CW_BAR) + XB_TMO, RLX_AGENT);
        for (int m = gw; m < S_; m += NGW) { f32x4* xr = (f32x4*)(xres + (size_t)m * DM) + F.lane; float rs = 1.0f / sqrtf(rsq[3 * S_ + m] * (1.0f / DM) + EPS);
            if (tmo) rs = __builtin_nanf("");
#pragma unroll
            for (int j = 0; j < 16; ++j) { const f32x4 a = xr[64 * j]; const f32x4 gn = *((const f32x4*)fn + F.lane + 64 * j); xr[64 * j] = a * rs * gn; } }
    }
#undef IN
#undef SEAM
}

#ifndef MK_N_LAUNCHES
#define MK_N_LAUNCHES 1
#endif
extern "C" void kernel_launch(void* const* d_in, const int* in_sizes, int n_in, void* d_out, int out_size, void* d_ws, size_t ws_size, hipStream_t stream) {
    static int grid = 0;
    if (grid == 0) {
        if (n_in != 19 || in_sizes[0] != S_ * DM || out_size != S_ * DM || ws_size < WS_END) { fprintf(stderr, "kernel_launch: unexpected shapes (n_in %d, in0 %d, out %d, ws %zu); nothing launched\n", n_in, n_in > 0 ? in_sizes[0] : -1, out_size, ws_size); grid = -1; return; }
        int dev = 0, cus = 0, per_cu = 0;
        if (hipGetDevice(&dev) != hipSuccess || hipDeviceGetAttribute(&cus, hipDeviceAttributeMultiprocessorCount, dev) != hipSuccess) { fprintf(stderr, "kernel_launch: device query failed\n"); grid = -1; return; }
        if (hipFuncSetAttribute((const void*)fwd_kernel, hipFuncAttributeMaxDynamicSharedMemorySize, LDS_BYTES) != hipSuccess) { fprintf(stderr, "kernel_launch: hipFuncSetAttribute failed\n"); grid = -1; return; }
        if (hipOccupancyMaxActiveBlocksPerMultiprocessor(&per_cu, (const void*)fwd_kernel, NWAVES * 64, LDS_BYTES) != hipSuccess || per_cu < 1) { fprintf(stderr, "kernel_launch: occupancy query reports %d workgroups per CU\n", per_cu); per_cu = 1; }
        (void)hipGetLastError();
        grid = cus;
    }
    if (grid < 0) return;
    if (hipMemsetAsync((char*)d_ws + WS_CTL, 0, CTL_ZERO_BYTES, stream) != hipSuccess) { fprintf(stderr, "kernel_launch: memset failed\n"); return; }
    Args a{};
    for (int i = 0; i < 19; ++i) a.in[i] = (const float*)d_in[i];
    a.pos = (const int*)d_in[IN_POS]; a.out = (float*)d_out; a.ws = (unsigned char*)d_ws;
#if MK_N_LAUNCHES == 1
    a.ph_lo = 0; a.ph_hi = NPHASE;
    hipLaunchKernelGGL(fwd_kernel, dim3(grid), dim3(NWAVES * 64), LDS_BYTES, stream, a);
#else
    for (int p = 0; p < NPHASE; ++p) { a.ph_lo = p; a.ph_hi = p + 1; hipLaunchKernelGGL(fwd_kernel, dim3(grid), dim3(NWAVES * 64), LDS_BYTES, stream, a); }
#endif
    const hipError_t le = hipPeekAtLastError();
    if (le != hipSuccess) fprintf(stderr, "kernel_launch: launch failed: %s\n", hipGetErrorName(le));
}
```

```cpp
#include <hip/hip_runtime.h>
#include <cstdio>
#include <cstdint>

namespace pg8 {
#define PG8_LAS __attribute__((address_space(3)))
typedef unsigned short bf16_t;
typedef short bf16x8 __attribute__((ext_vector_type(8)));
typedef float f32x4 __attribute__((ext_vector_type(4)));
typedef unsigned u32x4 __attribute__((ext_vector_type(4)));
constexpr int BM = 256, BK = 64, HALF = 128, HTB = HALF * BK * 2  , STAGE_BYTES = 8 * HTB, NXCD = 8, WGM = 8;

__host__ __device__ __forceinline__ int lds_byte(int r, int c) { const int st = (r >> 4) * 2 + (c >> 5), rr = r & 15, cc = c & 31, ob = rr * 64 + cc * 2; return st * 1024 + (ob ^ (((ob >> 9) & 1) << 5)); }
__host__ __device__ __forceinline__ void stage_rc(int b, int& R, int& C) { const int st = b / 1024, sb = b % 1024, swz = sb ^ (((sb >> 9) & 1) << 5); R = (st >> 1) * 16 + swz / 64; C = (st & 1) * 32 + (swz % 64) / 2; }
__host__ __device__ __forceinline__ int perm32(int rho) { const int n = rho >> 4, i = rho & 15; return 8 * (i >> 2) + 4 * n + (i & 3); }

struct Unit { int pm, pn, z; };
struct Gemm { const bf16_t* A; const bf16_t* Bt; int lda, ldb, K; };

struct SchedGrid {
    int nM, nN, nwg, G, c; size_t astep, bstep;
    __device__ __forceinline__ void init(int nM_, int nN_, int G_, int c_, int lda, int ldb) { nM = nM_; nN = nN_; nwg = nM * nN; G = G_; c = c_; astep = (size_t)BM * lda * 2; bstep = (size_t)BM * ldb * 2; }
    __device__ __forceinline__ bool next(int i, Unit& u) const {
        const long L = (long)i * G + c; if (L >= nwg) return false;
        int wgid = (int)L; { const int q = nwg / NXCD, r = nwg % NXCD, xcd = wgid % NXCD, off = wgid / NXCD; wgid = (xcd < r ? xcd * (q + 1) : r * (q + 1) + (xcd - r) * q) + off; }
        const int nig = WGM * nN, gid = wgid / nig, fm = gid * WGM, gsz = (nM - fm) < WGM ? (nM - fm) : WGM;
        u.pm = fm + ((wgid % nig) % gsz); u.pn = (wgid % nig) / gsz; u.z = 0; return true;
    }
    __device__ __forceinline__ size_t a_off(const Unit& u) const { return (size_t)u.pm * astep; }
    __device__ __forceinline__ size_t b_off(const Unit& u) const { return (size_t)u.pn * bstep; }
};

__device__ __forceinline__ unsigned cvt_pk_bf16(float lo, float hi) { unsigned r; asm volatile("v_cvt_pk_bf16_f32 %0, %1, %2" : "=v"(r) : "v"(lo), "v"(hi)); return r; }

template <class Epi, class Sched>
__device__ __forceinline__ void gemm_phase(PG8_LAS unsigned char* lds, const Gemm g, const Sched& S, const Epi& E) {
    const int tid = threadIdx.x, wid = __builtin_amdgcn_readfirstlane(tid >> 6), lane = tid & 63, wr = wid >> 2, wc = wid & 3, fr = lane & 15, fq = lane >> 4;
    int nt = g.K / BK; asm volatile("" : "+s"(nt));
    unsigned voffA[2], voffB[2];
#pragma unroll
    for (int i = 0; i < 2; ++i) { int R, C; stage_rc(tid * 16 + i * 8192, R, C); const int Rb = (R & ~31) + perm32(R & 31);
        voffA[i] = (unsigned)(R * g.lda + C) * 2u; voffB[i] = (unsigned)(Rb * g.ldb + C) * 2u; }
    const size_t kstep = (size_t)(BK * 2);
    const size_t hstepA = (size_t)HALF * g.lda * 2, hstepB = (size_t)HALF * g.ldb * 2;
    const unsigned ldsw = (unsigned)wid * 1024u;
    const int aoff = lds_byte(wr * 64 + fr, fq * 8), boff = lds_byte(wc * 32 + fr, fq * 8);
#define PG8_SA(b, h) (((b) * 2 + (h)) * HTB)
#define PG8_SB(b, h) ((4 + (b) * 2 + (h)) * HTB)
#define PG8_STAGE(bufoff, gbase, voff) do { _Pragma("unroll") for (int _i = 0; _i < 2; ++_i) \
        __builtin_amdgcn_global_load_lds((const unsigned*)((const char*)(gbase) + (voff)[_i]), (PG8_LAS unsigned*)(lds + (bufoff) + ldsw + _i * 8192), 16, 0, 0); } while (0)
#define PG8_LDA(dst, b, h) do { _Pragma("unroll") for (int m = 0; m < 4; ++m) _Pragma("unroll") for (int k = 0; k < 2; ++k) dst[m][k] = *(const PG8_LAS bf16x8*)(lds + PG8_SA(b, h) + aoff + m * 2048 + k * 1024); } while (0)
#define PG8_LDB(dst, b, h) do { _Pragma("unroll") for (int n = 0; n < 2; ++n) _Pragma("unroll") for (int k = 0; k < 2; ++k) dst[n][k] = *(const PG8_LAS bf16x8*)(lds + PG8_SB(b, h) + boff + n * 2048 + k * 1024); } while (0)
#define PG8_MMA(ai, bj, At, Bt) do { __builtin_amdgcn_s_setprio(1); _Pragma("unroll") for (int m = 0; m < 4; ++m) _Pragma("unroll") for (int n = 0; n < 2; ++n) _Pragma("unroll") for (int k = 0; k < 2; ++k) \
        acc[ai][bj][m][n] = __builtin_amdgcn_mfma_f32_16x16x32_bf16(Bt[n][k], At[m][k], acc[ai][bj][m][n], 0, 0, 0); __builtin_amdgcn_s_setprio(0); } while (0)
#define PG8_WAIT_V(n) asm volatile("s_waitcnt vmcnt(" #n ")" ::: "memory")
#define PG8_WAIT_L(n) asm volatile("s_waitcnt lgkmcnt(" #n ")" ::: "memory")
#define PG8_BAR __builtin_amdgcn_s_barrier()
#define PG8_SCHED __builtin_amdgcn_sched_barrier(0)
    Unit cur, nxt; int ui = 0;
    if (!S.next(0, cur)) return;
    f32x4 acc[2][2][4][2];
#pragma unroll
    for (int a = 0; a < 2; ++a)
#pragma unroll
        for (int b = 0; b < 2; ++b)
#pragma unroll
            for (int m = 0; m < 4; ++m)
#pragma unroll
                for (int n = 0; n < 2; ++n) acc[a][b][m][n] = (f32x4){0.f, 0.f, 0.f, 0.f};
    bf16x8 At[4][2], B0[2][2], B1[2][2];
    const char* cA = (const char*)g.A + S.a_off(cur); const char* cB = (const char*)g.Bt + S.b_off(cur);
    PG8_STAGE(PG8_SB(0, 0), cB, voffB); PG8_STAGE(PG8_SB(0, 1), cB + hstepB, voffB); PG8_STAGE(PG8_SA(0, 0), cA, voffA); PG8_STAGE(PG8_SA(0, 1), cA + hstepA, voffA);
    if (wr == 1) PG8_BAR;
    PG8_WAIT_V(2); PG8_BAR;
    PG8_STAGE(PG8_SB(1, 0), cB + kstep, voffB); PG8_STAGE(PG8_SA(1, 0), cA + kstep, voffA); PG8_STAGE(PG8_SB(1, 1), cB + hstepB + kstep, voffB);
    PG8_WAIT_V(6); PG8_BAR;
    for (;;) {
        const bool has_next = S.next(ui + 1, nxt);
        const char* nA = has_next ? (const char*)g.A + S.a_off(nxt) : cA; const char* nB = has_next ? (const char*)g.Bt + S.b_off(nxt) : cB;
        for (int t = 0; t < nt; t += 2) {
            const bool last = (t == nt - 2);
            const char* a1 = cA + (size_t)(t + 1) * kstep;
            const char* a2 = last ? nA : cA + (size_t)(t + 2) * kstep; const char* b2 = last ? nB : cB + (size_t)(t + 2) * kstep;
            const char* a3 = a2 + kstep; const char* b3 = b2 + kstep;
            PG8_LDB(B0, 0, 0); PG8_LDB(B1, 0, 1); PG8_SCHED; PG8_LDA(At, 0, 0); PG8_STAGE(PG8_SA(1, 1), a1 + hstepA, voffA);
            PG8_WAIT_V(8); PG8_WAIT_L(0); PG8_BAR; PG8_MMA(0, 0, At, B0); PG8_MMA(0, 1, At, B1); PG8_BAR; PG8_SCHED;
            PG8_LDA(At, 0, 1); PG8_STAGE(PG8_SB(0, 0), b2, voffB); PG8_STAGE(PG8_SB(0, 1), b2 + hstepB, voffB); PG8_STAGE(PG8_SA(0, 0), a2, voffA);
            PG8_WAIT_V(8); PG8_WAIT_L(0); PG8_BAR; PG8_MMA(1, 0, At, B0); PG8_MMA(1, 1, At, B1); PG8_BAR; PG8_SCHED;
            PG8_LDB(B0, 1, 0); PG8_LDB(B1, 1, 1); PG8_SCHED; PG8_LDA(At, 1, 0); PG8_STAGE(PG8_SA(0, 1), a2 + hstepA, voffA);
            PG8_WAIT_V(8); PG8_WAIT_L(0); PG8_BAR; PG8_MMA(0, 0, At, B0); PG8_MMA(0, 1, At, B1); PG8_BAR; PG8_SCHED;
            PG8_LDA(At, 1, 1); PG8_STAGE(PG8_SB(1, 0), b3, voffB); PG8_STAGE(PG8_SB(1, 1), b3 + hstepB, voffB); PG8_STAGE(PG8_SA(1, 0), a3, voffA);
            PG8_WAIT_V(8); PG8_WAIT_L(0); PG8_BAR; PG8_MMA(1, 0, At, B0); PG8_MMA(1, 1, At, B1); PG8_BAR; PG8_SCHED;
        }
        if (wr == 0) PG8_BAR;
        { int fr2 = fr, fq2 = fq; asm volatile("" : "+v"(fr2), "+v"(fq2));
          E(acc, cur, wr, wc, fr2, fq2); }
        if (!has_next) break;
#pragma unroll
        for (int a = 0; a < 2; ++a)
#pragma unroll
            for (int b = 0; b < 2; ++b)
#pragma unroll
                for (int m = 0; m < 4; ++m)
#pragma unroll
                    for (int n = 0; n < 2; ++n) acc[a][b][m][n] = (f32x4){0.f, 0.f, 0.f, 0.f};
        cur = nxt; cA = nA; cB = nB; ++ui;
        if (wr == 1) PG8_BAR;
    }
    PG8_WAIT_V(0);
    PG8_BAR;
#undef PG8_SA
#undef PG8_SB
#undef PG8_STAGE
#undef PG8_LDA
#undef PG8_LDB
#undef PG8_MMA
#undef PG8_WAIT_V
#undef PG8_WAIT_L
#undef PG8_BAR
#undef PG8_SCHED
}
}

constexpr int NWAVES = 8;
constexpr int S_ = 16384, DM = 4096, FF = 11008, PROJ = 10240, RD = 2048, NH = 8, HD = 256, CH = 256, NCH = S_ / CH, PD = 2048;
constexpr float EPS = 1e-6f;
constexpr int KCAT = 768;

constexpr size_t MiB = 1u << 20;
constexpr size_t WS_CTL = 0, CTL_ZERO_BYTES = 1 * MiB;
constexpr size_t WS_TAB = 1 * MiB;
constexpr size_t WS_CS = 2 * MiB;
constexpr size_t WS_WPOOL = 18 * MiB;
constexpr size_t WS_WIN = 20 * MiB, WS_WOUT = 100 * MiB, WS_WGU2 = 132 * MiB, WS_WD2 = 304 * MiB;
constexpr size_t WS_XB = 390 * MiB;
constexpr size_t WS_WGU1 = 518 * MiB, WS_WD1 = 690 * MiB, WS_ACT = 776 * MiB;
constexpr size_t WS_QROW = 518 * MiB, WS_KROW = 582 * MiB, WS_KDT = 646 * MiB  , WS_GS = 774 * MiB, WS_PB = 838 * MiB, WS_POOLED = 902 * MiB;
constexpr size_t WS_ACAT = 966 * MiB, WS_BCAT = 1158 * MiB, WS_END = 1350 * MiB;
constexpr size_t WS_MIX = 1350 * MiB, WS_END2 = 1478 * MiB;
static_assert(WS_WIN + (size_t)PROJ * DM * 2 <= WS_WOUT && WS_WOUT + (size_t)DM * DM * 2 <= WS_WGU2 && WS_WGU2 + (size_t)2 * FF * DM * 2 <= WS_WD2 && WS_WD2 + (size_t)DM * FF * 2 <= WS_XB, "weights map");
static_assert(WS_XB + (size_t)S_ * DM * 2 <= WS_WGU1 && WS_WGU1 + (size_t)2 * FF * DM * 2 <= WS_WD1 && WS_WD1 + (size_t)DM * FF * 2 <= WS_ACT && WS_ACT + (size_t)S_ * FF * 2 <= WS_END, "ffn map");
static_assert(WS_ACAT + (size_t)NH * S_ * KCAT * 2 <= WS_BCAT && WS_BCAT + (size_t)NH * NCH * HD * KCAT * 2 <= WS_END && WS_POOLED + (size_t)S_ * PD * 2 <= WS_ACAT, "mixer map");
constexpr int CW_BAR = 4096;
constexpr int CW_RSQ = 16384;

constexpr int RING_OFF = 0, RING_BYTES = 131072;
constexpr int LDS_BYTES = 147456;
constexpr int EPI_SCR_OFF = 135168;
constexpr int MISC_OFF = LDS_BYTES - 256;
constexpr int TR_LD = 65, TR_BYTES = 64 * TR_LD * 4;
static_assert(NWAVES * TR_BYTES <= EPI_SCR_OFF + 4096 && EPI_SCR_OFF + 4096 <= MISC_OFF, "LDS map");

#define GAS __attribute__((address_space(1)))
#define LAS __attribute__((address_space(3)))
typedef unsigned short bf16;
typedef unsigned v4u __attribute__((ext_vector_type(4)));
typedef unsigned v2u __attribute__((ext_vector_type(2)));
typedef float f32x4 __attribute__((ext_vector_type(4)));
typedef GAS unsigned gu32;
#define RLX_AGENT __ATOMIC_RELAXED, __HIP_MEMORY_SCOPE_AGENT
#define LDS_WAIT() asm volatile("s_waitcnt lgkmcnt(0)" ::: "memory")
#define VM_WAIT() asm volatile("s_waitcnt vmcnt(0)" ::: "memory")
__device__ __forceinline__ unsigned f2bf(float f) { unsigned u = __builtin_bit_cast(unsigned, f); return (u + 0x7fffu + ((u >> 16) & 1u)) >> 16; }
__device__ __forceinline__ unsigned pk2(float lo, float hi) { return pg8::cvt_pk_bf16(lo, hi); }
__device__ __forceinline__ float bf2f(unsigned h) { return __builtin_bit_cast(float, h << 16); }
__device__ __forceinline__ float fast_exp2(float x) { return __builtin_amdgcn_exp2f(x); }
__device__ __forceinline__ float silu_f(float x) { return x * __builtin_amdgcn_rcpf(1.0f + fast_exp2(-1.4426950408889634f * x)); }
__device__ __forceinline__ float log2_sigmoid(float x) { return -log1pf(expf(-x)) * 1.4426950408889634f; }

#define XB_TMO      128
#define XB_XCNT(j)  (256  + 64 * (j))
#define XB_XSUB(j)  (1280 + 64 * (j))
#define XB_XGEN(j)  (2304 + 64 * (j))
#define XB_TOP      3328
#define XB_TOPGEN   3392
#define XCD_BAR_WORDS 3456
#define XB_SPIN_CAP (1u << 18)

__device__ __forceinline__ unsigned xb_ld(unsigned* p)              { return __hip_atomic_load(p, __ATOMIC_RELAXED, __HIP_MEMORY_SCOPE_AGENT); }
__device__ __forceinline__ unsigned xb_add(unsigned* p, unsigned v) { return __hip_atomic_fetch_add(p, v, __ATOMIC_RELAXED, __HIP_MEMORY_SCOPE_AGENT); }
__device__ __forceinline__ unsigned xb_xcc_id() { return (unsigned)__builtin_amdgcn_s_getreg((3 << 11) | 20) & 0xFu; }
#define XB_SPIN(cond, bar) do { unsigned _sp = 0; while (cond) { __builtin_amdgcn_s_sleep(1); \
    if ((++_sp & 255u) == 0u) { if (xb_ld(&(bar)[XB_TMO])) break; if (_sp > XB_SPIN_CAP) { atomicAdd(&(bar)[XB_TMO], 1u); break; } } } } while (0)

struct XcdBarrier {
    unsigned* bar; unsigned x;
    volatile LAS unsigned* st;
};
__device__ __forceinline__ XcdBarrier xcd_barrier_post(unsigned* bar, volatile LAS unsigned* st) {
    XcdBarrier b; b.bar = bar; b.x = xb_xcc_id(); b.st = st;
    if (threadIdx.x == 0) (void)xb_add(&bar[XB_XCNT(b.x)], 1u);
    return b;
}
__device__ __forceinline__ void xcd_barrier_complete(unsigned* bar, unsigned x, unsigned& nloc, unsigned& nx) {
    const unsigned G = gridDim.x * gridDim.y * gridDim.z;
    unsigned sum, cnt, mine, sp = 0u;
    for (;;) {
        sum = 0u; cnt = 0u; mine = 0u;
#pragma unroll
        for (unsigned j = 0; j < 16; ++j) { const unsigned c = xb_ld(&bar[XB_XCNT(j)]); sum += c; cnt += (c > 0u) ? 1u : 0u; mine = (j == x) ? c : mine; }
        if (sum == G) break;
        __builtin_amdgcn_s_sleep(1);
        if ((++sp & 255u) == 0u) { if (xb_ld(&bar[XB_TMO])) break; if (sp > XB_SPIN_CAP) { atomicAdd(&bar[XB_TMO], 1u); break; } }
    }
    nloc = mine > 0u ? mine : 1u; nx = cnt > 0u ? cnt : 1u;
}
__device__ __forceinline__ void xcd_barrier(const XcdBarrier& b) {
    asm volatile("s_waitcnt vmcnt(0)" ::: "memory");
    __syncthreads();
    if (threadIdx.x == 0) {
        unsigned* bar = b.bar;
        __builtin_amdgcn_s_waitcnt(0);
        unsigned nloc = b.st[0], nx = b.st[1];
        if (nloc == 0u) { xcd_barrier_complete(bar, b.x, nloc, nx); b.st[0] = nloc; b.st[1] = nx; }
        const unsigned old = xb_add(&bar[XB_XSUB(b.x)], 1u);
        const unsigned gen = old / nloc;
        if (old + 1u == (gen + 1u) * nloc) {
            __builtin_amdgcn_fence(__ATOMIC_RELEASE, "agent");
            asm volatile("s_waitcnt vmcnt(0)" ::: "memory");
            const unsigned og = xb_add(&bar[XB_TOP], 1u);
            const unsigned tg = og / nx;
            if (og + 1u == (tg + 1u) * nx) xb_add(&bar[XB_TOPGEN], 1u);
            else XB_SPIN(xb_ld(&bar[XB_TOPGEN]) == tg, bar);
            __builtin_amdgcn_fence(__ATOMIC_ACQUIRE, "agent");
            xb_add(&bar[XB_XGEN(b.x)], 1u);
            asm volatile("s_waitcnt vmcnt(0)" ::: "memory");
        } else {
            XB_SPIN(xb_ld(&bar[XB_XGEN(b.x)]) == gen, bar);
            __builtin_amdgcn_fence(__ATOMIC_ACQUIRE, "agent");
            asm volatile("s_waitcnt vmcnt(0)" ::: "memory");
        }
    }
    __syncthreads();
}

using pg8::Unit;
typedef pg8::f32x4 accv;

__device__ __forceinline__ v4u pack8(const accv& v0, const accv& v1) { v4u w; w.x = pk2(v0[0], v0[1]); w.y = pk2(v0[2], v0[3]); w.z = pk2(v1[0], v1[1]); w.w = pk2(v1[2], v1[3]); return w; }

struct EpiGateUp {
    static constexpr bool PERM = true;
    const float* rowsq; bf16* act;
    __device__ __forceinline__ void operator()(const accv (&acc)[2][2][4][2], const Unit& u, int wr, int wc, int fr, int fq) const {
        const int row0 = u.pm * 256 + wr * 64 + fr, col0 = u.pn * 128 + wc * 32 + 8 * fq;
#pragma unroll
        for (int ai = 0; ai < 2; ++ai)
#pragma unroll
            for (int m = 0; m < 4; ++m) { const int row = row0 + ai * 128 + m * 16; const float rs = 1.0f / sqrtf(rowsq[row] * (1.0f / DM) + EPS);
                accv o[2];
#pragma unroll
                for (int n = 0; n < 2; ++n)
#pragma unroll
                    for (int j = 0; j < 4; ++j) { const float g = acc[ai][0][m][n][j] * rs, up = acc[ai][1][m][n][j] * rs; o[n][j] = silu_f(g) * up; }
                *(v4u*)(act + (size_t)row * FF + col0) = pack8(o[0], o[1]); }
    }
};

__device__ __forceinline__ void unpack8(const v4u& w, accv& a, accv& b) { a[0] = bf2f(w.x & 0xffffu); a[1] = bf2f(w.x >> 16); a[2] = bf2f(w.y & 0xffffu); a[3] = bf2f(w.y >> 16);
    b[0] = bf2f(w.z & 0xffffu); b[1] = bf2f(w.z >> 16); b[2] = bf2f(w.w & 0xffffu); b[3] = bf2f(w.w >> 16); }
struct EpiResid {
    static constexpr bool PERM = true;
    bf16* xs; float* rowsq; float scale;
    __device__ __forceinline__ void operator()(const accv (&acc)[2][2][4][2], const Unit& u, int wr, int wc, int fr, int fq) const {
        const int row0 = u.pm * 256 + wr * 64 + fr, col0 = u.pn * 256 + wc * 32 + 8 * fq;
        v4u xo[2][4][2];
#pragma unroll
        for (int ai = 0; ai < 2; ++ai)
#pragma unroll
            for (int m = 0; m < 4; ++m)
#pragma unroll
                for (int bj = 0; bj < 2; ++bj) xo[ai][m][bj] = *(const v4u*)(xs + (size_t)(row0 + ai * 128 + m * 16) * DM + col0 + bj * 128);
        asm volatile("" ::: "memory");
#pragma unroll
        for (int ai = 0; ai < 2; ++ai)
#pragma unroll
            for (int m = 0; m < 4; ++m) { const int row = row0 + ai * 128 + m * 16; const size_t off = (size_t)row * DM + col0; float ss = 0.f;
#pragma unroll
                for (int bj = 0; bj < 2; ++bj) { accv v0, v1; unpack8(xo[ai][m][bj], v0, v1);
                    v0 = v0 + acc[ai][bj][m][0] * scale; v1 = v1 + acc[ai][bj][m][1] * scale;
                    ss += (v0[0] * v0[0] + v0[1] * v0[1]) + (v0[2] * v0[2] + v0[3] * v0[3]) + (v1[0] * v1[0] + v1[1] * v1[1]) + (v1[2] * v1[2] + v1[3] * v1[3]);
                    *(v4u*)(xs + off + bj * 128) = pack8(v0, v1); }
                ss += __shfl_xor(ss, 16); ss += __shfl_xor(ss, 32);
                if (fq == 0) atomicAdd(rowsq + row, ss); }
    }
};

struct EpiZ {
    static constexpr bool PERM = true;
    const float* rowsq; const float* cs; const float* l2tab;
    bf16 *qrow, *krow, *kdt, *gs, *pb, *acat, *bcat;
    __device__ __forceinline__ void operator()(const accv (&acc)[2][2][4][2], const Unit& u, int wr, int wc, int fr, int fq) const {
        const int type = u.pn >> 3, h = u.pn & 7, c = u.pm;
        const int i0 = wr * 64 + fr, d1 = wc * 32 + 8 * fq;
        if (type <= 1) {
            const float l2a = l2tab[h], l2b = l2tab[8 + h];
#pragma unroll
            for (int ai = 0; ai < 2; ++ai)
#pragma unroll
                for (int m = 0; m < 4; ++m) { const int i = i0 + ai * 128 + m * 16, s = c * 256 + i;
                    const float rs = 1.0f / sqrtf(rowsq[s] * (1.0f / DM) + EPS);
                    const accv c0 = *(const accv*)(cs + (size_t)s * 128 + d1), c1 = *(const accv*)(cs + (size_t)s * 128 + d1 + 4);
                    const accv s0 = *(const accv*)(cs + (size_t)S_ * 128 + (size_t)s * 128 + d1), s1 = *(const accv*)(cs + (size_t)S_ * 128 + (size_t)s * 128 + d1 + 4);
                    accv r1[2], r2[2];
                    r1[0] = acc[ai][0][m][0] * c0 - acc[ai][1][m][0] * s0; r1[1] = acc[ai][0][m][1] * c1 - acc[ai][1][m][1] * s1;
                    r2[0] = acc[ai][0][m][0] * s0 + acc[ai][1][m][0] * c0; r2[1] = acc[ai][0][m][1] * s1 + acc[ai][1][m][1] * c1;
                    if (type == 0) {
                        const size_t o = (size_t)s * RD + h * 256 + d1;
                        *(v4u*)(qrow + o) = pack8(r1[0] * rs, r1[1] * rs); *(v4u*)(qrow + o + 128) = pack8(r2[0] * rs, r2[1] * rs);
                        const float sf = rs * fast_exp2(l2a * (float)(i + 1)), sb = rs * fast_exp2(l2b * (float)(CH - i));
                        const size_t oa = ((size_t)h * S_ + s) * KCAT + 256 + d1;
                        *(v4u*)(acat + oa) = pack8(r1[0] * sf, r1[1] * sf); *(v4u*)(acat + oa + 128) = pack8(r2[0] * sf, r2[1] * sf);
                        *(v4u*)(acat + oa + 256) = pack8(r1[0] * sb, r1[1] * sb); *(v4u*)(acat + oa + 384) = pack8(r2[0] * sb, r2[1] * sb);
                    } else {
                        const float rk = rs * 0.0625f;
                        const size_t o = (size_t)s * RD + h * 256 + d1;
                        *(v4u*)(krow + o) = pack8(r1[0] * rk, r1[1] * rk); *(v4u*)(krow + o + 128) = pack8(r2[0] * rk, r2[1] * rk);
                        const float sf = rk * fast_exp2(l2a * (float)(CH - 1 - i)), sb = rk * fast_exp2(l2b * (float)i);
                        bf16* tf = kdt + ((size_t)h * 256 + d1) * S_ + s; bf16* tb = tf + (size_t)RD * S_;
#pragma unroll
                        for (int n = 0; n < 2; ++n)
#pragma unroll
                            for (int j = 0; j < 4; ++j) { const size_t t = (size_t)(4 * n + j) * S_;
                                tf[t] = (bf16)f2bf(r1[n][j] * sf); tf[t + (size_t)128 * S_] = (bf16)f2bf(r2[n][j] * sf);
                                tb[t] = (bf16)f2bf(r1[n][j] * sb); tb[t + (size_t)128 * S_] = (bf16)f2bf(r2[n][j] * sb); }
                    }
                    asm volatile("" ::: "memory"); }
        } else if (type == 2) {
            bf16* base = bcat + ((size_t)(h * NCH + c) * 256) * KCAT;
#pragma unroll
            for (int ai = 0; ai < 2; ++ai)
#pragma unroll
                for (int m = 0; m < 4; ++m) { const int i = i0 + ai * 128 + m * 16, s = c * 256 + i;
                    const float rs = 1.0f / sqrtf(rowsq[s] * (1.0f / DM) + EPS);
#pragma unroll
                    for (int bj = 0; bj < 2; ++bj)
#pragma unroll
                        for (int n = 0; n < 2; ++n)
#pragma unroll
                            for (int j = 0; j < 4; ++j) base[(size_t)(bj * 128 + d1 + 4 * n + j) * KCAT + i] = (bf16)f2bf(acc[ai][bj][m][n][j] * rs); }
        } else {
            bf16* dst = (type == 3) ? gs : pb;
#pragma unroll
            for (int ai = 0; ai < 2; ++ai)
#pragma unroll
                for (int m = 0; m < 4; ++m) { const int i = i0 + ai * 128 + m * 16, s = c * 256 + i;
                    const float rs = 1.0f / sqrtf(rowsq[s] * (1.0f / DM) + EPS);
#pragma unroll
                    for (int bj = 0; bj < 2; ++bj) { accv v0 = acc[ai][bj][m][0] * rs, v1 = acc[ai][bj][m][1] * rs;
                        if (type == 3) {
#pragma unroll
                            for (int j = 0; j < 4; ++j) { v0[j] = silu_f(v0[j]); v1[j] = silu_f(v1[j]); } }
                        *(v4u*)(dst + (size_t)s * RD + h * 256 + bj * 128 + d1) = pack8(v0, v1); } }
        }
    }
};

struct EpiKV {
    static constexpr bool PERM = true;
    bf16* bcat;
    __device__ __forceinline__ void operator()(const accv (&acc)[2][2][4][2], const Unit& u, int wr, int wc, int fr, int fq) const {
        bf16* base = bcat + ((size_t)(u.pn * NCH + u.pm) * 256) * KCAT + 256 + 256 * u.z + wc * 32 + 8 * fq;
        const int r0 = wr * 64 + fr;
#pragma unroll
        for (int ai = 0; ai < 2; ++ai)
#pragma unroll
            for (int m = 0; m < 4; ++m) { bf16* rp = base + (size_t)(r0 + ai * 128 + m * 16) * KCAT;
#pragma unroll
                for (int bj = 0; bj < 2; ++bj) *(v4u*)(rp + bj * 128) = pack8(acc[ai][bj][m][0], acc[ai][bj][m][1]); }
    }
};

struct EpiS {
    static constexpr bool PERM = true;
    const float* l2tab; bf16* acat;
    __device__ __forceinline__ void operator()(const accv (&acc)[2][2][4][2], const Unit& u, int wr, int wc, int fr, int fq) const {
        const int h = u.pn, c = u.pm;
        float l2a = l2tab[h], l2b = l2tab[8 + h];
        const int i0 = wr * 64 + fr, j0 = wc * 32 + 8 * fq;
        bf16* base = acat + ((size_t)h * S_ + (size_t)c * 256) * KCAT + j0;
#pragma unroll
        for (int ai = 0; ai < 2; ++ai)
#pragma unroll
            for (int m = 0; m < 4; ++m) { const int i = i0 + ai * 128 + m * 16;
#pragma unroll
                for (int bj = 0; bj < 2; ++bj) { accv v[2];
#pragma unroll
                    for (int n = 0; n < 2; ++n)
#pragma unroll
                        for (int j = 0; j < 4; ++j) { const float dd = (float)(i - (bj * 128 + j0 + 4 * n + j)); const float e = l2a * fmaxf(dd, 0.f) - l2b * fminf(dd, 0.f); v[n][j] = acc[ai][bj][m][n][j] * fast_exp2(e); }
                    *(v4u*)(base + (size_t)i * KCAT + bj * 128) = pack8(v[0], v[1]); }
                asm volatile("" : "+v"(l2a), "+v"(l2b) :: "memory"); }
    }
};

struct EpiPool {
    static constexpr bool PERM = true;
    const float* pscale; bf16* mix;
    __device__ __forceinline__ void operator()(const accv (&acc)[2][2][4][2], const Unit& u, int wr, int wc, int fr, int fq) const {
        const int row0 = u.pm * 256 + wr * 64 + fr, colp = u.pn * 256 + wc * 32 + 8 * fq;
        accv sc[2][2];
#pragma unroll
        for (int bj = 0; bj < 2; ++bj)
#pragma unroll
            for (int n = 0; n < 2; ++n) sc[bj][n] = *(const accv*)(pscale + colp + bj * 128 + 4 * n);
#pragma unroll
        for (int ai = 0; ai < 2; ++ai)
#pragma unroll
            for (int m = 0; m < 4; ++m) { bf16* rp = mix + (size_t)(row0 + ai * 128 + m * 16) * DM + RD + colp;
#pragma unroll
                for (int bj = 0; bj < 2; ++bj) *(v4u*)(rp + bj * 128) = pack8(acc[ai][bj][m][0] * sc[bj][0], acc[ai][bj][m][1] * sc[bj][1]); }
    }
};

struct EpiOut {
    static constexpr bool PERM = true;
    const float* hnorm; const bf16* gs; bf16* mix; LAS float* scr;
    __device__ __forceinline__ void operator()(const accv (&acc)[2][2][4][2], const Unit& u, int wr, int wc, int fr, int fq) const {
        const int h = u.pn, c = u.pm; const int i0 = wr * 64 + fr, e0 = wc * 32 + 8 * fq;
#pragma unroll
        for (int ai = 0; ai < 2; ++ai)
#pragma unroll
            for (int m = 0; m < 4; ++m) { float ss = 0.f;
#pragma unroll
                for (int bj = 0; bj < 2; ++bj)
#pragma unroll
                    for (int n = 0; n < 2; ++n) { const accv x = acc[ai][bj][m][n]; ss += (x[0] * x[0] + x[1] * x[1]) + (x[2] * x[2] + x[3] * x[3]); }
                ss += __shfl_xor(ss, 16); ss += __shfl_xor(ss, 32);
                if (fq == 0) scr[(i0 + ai * 128 + m * 16) * 4 + wc] = ss; }
        asm volatile("s_waitcnt lgkmcnt(0)" ::: "memory"); __builtin_amdgcn_s_barrier(); asm volatile("" ::: "memory");
        accv hn[2][2];
#pragma unroll
        for (int bj = 0; bj < 2; ++bj)
#pragma unroll
            for (int n = 0; n < 2; ++n) hn[bj][n] = *(const accv*)(hnorm + h * 256 + bj * 128 + e0 + 4 * n);
#pragma unroll
        for (int ai = 0; ai < 2; ++ai)
#pragma unroll
            for (int m = 0; m < 4; ++m) { const int i = i0 + ai * 128 + m * 16; const accv p = *(const LAS accv*)(scr + i * 4);
                const float rn = 1.0f / sqrtf(((p[0] + p[1]) + (p[2] + p[3])) * (1.0f / HD) + EPS);
                const size_t o = (size_t)(c * 256 + i) * RD + h * 256 + e0;
#pragma unroll
                for (int bj = 0; bj < 2; ++bj) { const v4u gv = *(const v4u*)(gs + o + bj * 128);
                    accv g0, g1; g0[0] = bf2f(gv.x & 0xffffu); g0[1] = bf2f(gv.x >> 16); g0[2] = bf2f(gv.y & 0xffffu); g0[3] = bf2f(gv.y >> 16);
                    g1[0] = bf2f(gv.z & 0xffffu); g1[1] = bf2f(gv.z >> 16); g1[2] = bf2f(gv.w & 0xffffu); g1[3] = bf2f(gv.w >> 16);
                    *(v4u*)(mix + (size_t)(c * 256 + i) * DM + h * 256 + bj * 128 + e0) = pack8(acc[ai][bj][m][0] * rn * hn[bj][0] * g0, acc[ai][bj][m][1] * rn * hn[bj][1] * g1); } }
        asm volatile("s_waitcnt lgkmcnt(0)" ::: "memory"); __builtin_amdgcn_s_barrier(); asm volatile("" ::: "memory");
    }
};

struct SchedKV {
    int G, c;
    __device__ __forceinline__ bool next(int i, Unit& u) const { const int L = i * G + c; if (L >= NH * NCH * 2) return false; u.z = L & 1; u.pm = (L >> 1) & (NCH - 1); u.pn = L >> 7; return true; }
    __device__ __forceinline__ size_t a_off(const Unit& u) const { return ((size_t)(u.pn * NCH + u.pm) * 256 * KCAT) * 2; }
    __device__ __forceinline__ size_t b_off(const Unit& u) const { return ((size_t)u.z * RD * S_ + (size_t)u.pn * 256 * S_ + (size_t)u.pm * 256) * 2; }
};
struct SchedS {
    int G, c;
    __device__ __forceinline__ bool next(int i, Unit& u) const { const int L = i * G + c; if (L >= NH * NCH) return false; u.z = 0; u.pm = L & (NCH - 1); u.pn = L >> 6; return true; }
    __device__ __forceinline__ size_t a_off(const Unit& u) const { return ((size_t)u.pm * 256 * RD + (size_t)u.pn * 256) * 2; }
    __device__ __forceinline__ size_t b_off(const Unit& u) const { return a_off(u); }
};
struct SchedPool {
    int G, c;
    __device__ __forceinline__ bool next(int i, Unit& u) const { const int L = i * G + c; if (L >= NCH * 8) return false; u.z = 0; u.pn = L & 7; u.pm = L >> 3; return true; }
    __device__ __forceinline__ size_t a_off(const Unit& u) const { return ((size_t)u.pm * 256 * PD + (size_t)(u.pn >> 1) * 512) * 2; }
    __device__ __forceinline__ size_t b_off(const Unit& u) const { return ((size_t)u.pn * 256 * 512) * 2; }
};
struct SchedOut {
    int G, c;
    __device__ __forceinline__ bool next(int i, Unit& u) const { const int L = i * G + c; if (L >= NH * NCH) return false; u.z = 0; u.pm = L & (NCH - 1); u.pn = L >> 6; return true; }
    __device__ __forceinline__ size_t a_off(const Unit& u) const { return (((size_t)u.pn * S_ + (size_t)u.pm * 256) * KCAT) * 2; }
    __device__ __forceinline__ size_t b_off(const Unit& u) const { return ((size_t)(u.pn * NCH + u.pm) * 256 * KCAT) * 2; }
};

struct Frame {
    LAS unsigned char* lds;
    volatile LAS unsigned* MISC;
    int tid, lane, wave, G;
};

__device__ __forceinline__ float wave_sum(float v) {
#pragma unroll
    for (int o = 1; o < 64; o <<= 1) v += __shfl_xor(v, o);
    return v;
}

__device__ __forceinline__ void tr_item(const float* __restrict__ W, int K, int N, const float* __restrict__ gain, bf16* WT, int blk, int dblk, int doff, LAS float* scr, int item, int lane) {
    const int nblk = N / 64, kb = item / nblk, nb = item % nblk, k0 = 64 * kb, n0 = 64 * nb;
    const int lr = lane >> 4, lc = (lane & 15) * 4;
    f32x4 v[16];
#pragma unroll
    for (int i = 0; i < 16; ++i) v[i] = *(const f32x4*)(W + (size_t)(k0 + lr + 4 * i) * N + n0 + lc);
#pragma unroll
    for (int i = 0; i < 16; ++i) { const int kk = lr + 4 * i; const float gsc = gain ? gain[k0 + kk] : 1.0f; LAS float* d = scr + kk * TR_LD + lc;
        d[0] = v[i][0] * gsc; d[1] = v[i][1] * gsc; d[2] = v[i][2] * gsc; d[3] = v[i][3] * gsc; }
    LDS_WAIT(); asm volatile("" ::: "memory");
    const int cc = lane & 7;
    const int drow0 = (n0 / blk) * dblk + doff + (n0 % blk);
#pragma unroll
    for (int j = 0; j < 8; ++j) { const int n = (lane >> 3) + 8 * j; const LAS float* s = scr + (8 * cc) * TR_LD + n;
        v4u o; o.x = pk2(s[0 * TR_LD], s[1 * TR_LD]); o.y = pk2(s[2 * TR_LD], s[3 * TR_LD]); o.z = pk2(s[4 * TR_LD], s[5 * TR_LD]); o.w = pk2(s[6 * TR_LD], s[7 * TR_LD]);
        *(v4u*)(WT + (size_t)(drow0 + n) * K + k0 + 8 * cc) = o; }
    LDS_WAIT(); asm volatile("" ::: "memory");
}
__device__ __forceinline__ void tr_matrix(Frame& F, const float* W, int K, int N, const float* gain, bf16* WT, int blk, int dblk, int doff) {
    LAS float* scr = (LAS float*)(F.lds + F.wave * TR_BYTES);
    const int gw = blockIdx.x * NWAVES + F.wave, NGW = F.G * NWAVES, nitems = (K / 64) * (N / 64);
    for (int it = gw; it < nitems; it += NGW) tr_item(W, K, N, gain, WT, blk, dblk, doff, scr, it, F.lane);
}

struct Args { const float* in[19]; const int* pos; float* out; unsigned char* ws; int ph_lo, ph_hi; };
static_assert(sizeof(Args) == 19 * 8 + 8 + 8 + 8 + 8, "Args has no padding");

enum { IN_X = 0, IN_POS = 1, IN_F1N = 2, IN_F1G = 3, IN_F1U = 4, IN_F1D = 5, IN_MIXN = 6, IN_WIN = 7, IN_DECF = 8, IN_DECB = 9, IN_HNORM = 10, IN_POOLW = 11, IN_PSCALE = 12,
       IN_WOUT = 13, IN_F2N = 14, IN_F2G = 15, IN_F2U = 16, IN_F2D = 17, IN_FINN = 18 };
constexpr int NPHASE = 11;
#ifndef MK_DUP
#define MK_DUP (-1)
#endif
#ifndef MK_PHASE_MASK
#define MK_PHASE_MASK 0x7ff
#endif

typedef const __attribute__((address_space(4))) Args* KArgs;
__device__ __forceinline__ KArgs kargs() { KArgs p = (KArgs)__builtin_amdgcn_kernarg_segment_ptr(); asm volatile("" : "+s"(p)); return p; }
#define GP(T, p) ((T*)(GAS T*)(p))
__device__ __forceinline__ void grid_sync(Frame& F) {
    KArgs ap = kargs(); XcdBarrier b; b.bar = (unsigned*)(GP(unsigned char, ap->ws) + WS_CTL) + CW_BAR; b.x = xb_xcc_id(); b.st = F.MISC + 8; xcd_barrier(b);
}

__global__ void __launch_bounds__(NWAVES * 64, 2) fwd_kernel(Args args) {
    extern __shared__ __attribute__((aligned(16))) unsigned char lds[];
    Frame F;
    F.lds = (LAS unsigned char*)lds;
    F.MISC = (volatile LAS unsigned*)(F.lds + MISC_OFF);
    F.tid = threadIdx.x; F.lane = F.tid & 63; F.wave = __builtin_amdgcn_readfirstlane(F.tid >> 6);
    F.G = gridDim.x;
    if (F.tid < 64) F.MISC[F.tid] = 0u;
    __syncthreads();
    { KArgs ap = kargs(); (void)xcd_barrier_post((unsigned*)(GP(unsigned char, ap->ws) + WS_CTL) + CW_BAR, F.MISC + 8); }
    const int lo = args.ph_lo, hi = args.ph_hi;
#define IN(k) (lo <= (k) && (k) < hi)
#define PHON(k) (((MK_PHASE_MASK) >> (k)) & 1)
#define SEAM(k) do { if (IN(k) && IN((k) + 1)) grid_sync(F); } while (0)
#if MK_DUP == 0
#define RL0 for (int rep = 0; rep < 2; ++rep)
#else
#define RL0 if (const int rep = 0; true)
#endif
#if MK_DUP == 1
#define RL1 for (int rep = 0; rep < 2; ++rep)
#else
#define RL1 if (const int rep = 0; true)
#endif
#if MK_DUP == 2
#define RL2 for (int rep = 0; rep < 2; ++rep)
#else
#define RL2 if (const int rep = 0; true)
#endif
#if MK_DUP == 3
#define RL3 for (int rep = 0; rep < 2; ++rep)
#else
#define RL3 if (const int rep = 0; true)
#endif
#if MK_DUP == 4
#define RL4 for (int rep = 0; rep < 2; ++rep)
#else
#define RL4 if (const int rep = 0; true)
#endif
#if MK_DUP == 5
#define RL5 for (int rep = 0; rep < 2; ++rep)
#else
#define RL5 if (const int rep = 0; true)
#endif
#if MK_DUP == 6
#define RL6 for (int rep = 0; rep < 2; ++rep)
#else
#define RL6 if (const int rep = 0; true)
#endif
#if MK_DUP == 7
#define RL7 for (int rep = 0; rep < 2; ++rep)
#else
#define RL7 if (const int rep = 0; true)
#endif
#if MK_DUP == 8
#define RL8 for (int rep = 0; rep < 2; ++rep)
#else
#define RL8 if (const int rep = 0; true)
#endif
#if MK_DUP == 9
#define RL9 for (int rep = 0; rep < 2; ++rep)
#else
#define RL9 if (const int rep = 0; true)
#endif
#if MK_DUP == 10
#define RL10 for (int rep = 0; rep < 2; ++rep)
#else
#define RL10 if (const int rep = 0; true)
#endif
#define PHASE(k) if (PHON(k) && IN(k)) RL##k
#define PHASE_ENV KArgs ap = kargs(); unsigned char* ws = GP(unsigned char, ap->ws); float* rsq = (float*)(ws + WS_CTL) + CW_RSQ; float* xres = GP(float, ap->out); bf16* xb = (bf16*)(ws + WS_XB); \
    float* const dum_rs = (float*)(ws + WS_TAB + 65536); (void)rsq; (void)xres; (void)xb; (void)dum_rs; if (rep) grid_sync(F)
#define AIN(k) GP(const float, ap->in[k])
    const int gw = blockIdx.x * NWAVES + F.wave, NGW = F.G * NWAVES;
    const int gt = blockIdx.x * (NWAVES * 64) + F.tid, NGT = F.G * NWAVES * 64;

    PHASE(0) { PHASE_ENV;
        tr_matrix(F, AIN(IN_F1G), DM, FF, AIN(IN_F1N), (bf16*)(ws + WS_WGU1), 128, 256, 0);
        tr_matrix(F, AIN(IN_F1U), DM, FF, AIN(IN_F1N), (bf16*)(ws + WS_WGU1), 128, 256, 128);
        tr_matrix(F, AIN(IN_F1D), FF, DM, nullptr, (bf16*)(ws + WS_WD1), DM, 0, 0);
        tr_matrix(F, AIN(IN_WIN), DM, PROJ, AIN(IN_MIXN), (bf16*)(ws + WS_WIN), PROJ, 0, 0);
        tr_matrix(F, AIN(IN_WOUT), DM, DM, nullptr, (bf16*)(ws + WS_WOUT), DM, 0, 0);
        tr_matrix(F, AIN(IN_F2G), DM, FF, AIN(IN_F2N), (bf16*)(ws + WS_WGU2), 128, 256, 0);
        tr_matrix(F, AIN(IN_F2U), DM, FF, AIN(IN_F2N), (bf16*)(ws + WS_WGU2), 128, 256, 128);
        tr_matrix(F, AIN(IN_F2D), FF, DM, nullptr, (bf16*)(ws + WS_WD2), DM, 0, 0);
#pragma unroll 1
        for (int g = 0; g < 4; ++g) tr_matrix(F, AIN(IN_POOLW) + (size_t)g * 512 * 512, 512, 512, nullptr, (bf16*)(ws + WS_WPOOL) + (size_t)g * 512 * 512, 512, 0, 0);
        const float* x = AIN(IN_X);
        for (int m = gw; m < S_; m += NGW) {
            const f32x4* xr = (const f32x4*)(x + (size_t)m * DM) + F.lane; float ss = 0.f;
#pragma unroll
            for (int j = 0; j < 16; j += 2) { const f32x4 a = xr[64 * j], b = xr[64 * (j + 1)];
                ss += (a[0] * a[0] + a[1] * a[1]) + (a[2] * a[2] + a[3] * a[3]) + (b[0] * b[0] + b[1] * b[1]) + (b[2] * b[2] + b[3] * b[3]);
                v2u pa, pbv; pa.x = pk2(a[0], a[1]); pa.y = pk2(a[2], a[3]); pbv.x = pk2(b[0], b[1]); pbv.y = pk2(b[2], b[3]);
                *((v2u*)(xb + (size_t)m * DM) + F.lane + 64 * j) = pa; *((v2u*)(xb + (size_t)m * DM) + F.lane + 64 * (j + 1)) = pbv; }
            ss = wave_sum(ss);
            if (F.lane == 0) rsq[m] = ss;
        }
        if (gt < 16) ((float*)(ws + WS_TAB))[gt] = log2_sigmoid((gt < 8 ? AIN(IN_DECF) : AIN(IN_DECB))[gt & 7]);
        float* cst = (float*)(ws + WS_CS); const int* pos = GP(const int, ap->pos);
        for (int t = gt; t < S_ * 128; t += NGT) { const int s = t >> 7, i = t & 127;
            const float pw = (float)pow(10000.0, (double)((float)i * (1.0f / 128.0f))); const float fr = 1.0f / pw;
            const float ang = (float)pos[s] * fr;
            const double rev = (double)ang * 0.15915494309189533577; const float fr_rev = (float)(rev - rint(rev));
            cst[t] = __builtin_amdgcn_cosf(fr_rev); cst[(size_t)S_ * 128 + t] = __builtin_amdgcn_sinf(fr_rev); }
    }
    SEAM(0);

    PHASE(1) { PHASE_ENV;
        pg8::Gemm g{xb, (const bf16*)(ws + WS_WGU1), DM, DM, DM}; pg8::SchedGrid S; S.init(S_ / 256, 2 * FF / 256, F.G, (int)blockIdx.x, DM, DM);
        EpiGateUp E{rsq, (bf16*)(ws + WS_ACT)};
        pg8::gemm_phase(F.lds + RING_OFF, g, S, E);
    }
    SEAM(1);
    PHASE(2) { PHASE_ENV;
        pg8::Gemm g{(const bf16*)(ws + WS_ACT), (const bf16*)(ws + WS_WD1), FF, FF, FF}; pg8::SchedGrid S; S.init(S_ / 256, DM / 256, F.G, (int)blockIdx.x, FF, FF);
        EpiResid E{rep ? (bf16*)(ws + WS_ACAT) : xb, rep ? dum_rs : rsq + S_, 0.5f};
        pg8::gemm_phase(F.lds + RING_OFF, g, S, E);
    }
    SEAM(2);
    PHASE(3) { PHASE_ENV;
        pg8::Gemm g{xb, (const bf16*)(ws + WS_WIN), DM, DM, DM}; pg8::SchedGrid S; S.init(S_ / 256, PROJ / 256, F.G, (int)blockIdx.x, DM, DM);
        EpiZ E{rsq + S_, (const float*)(ws + WS_CS), (const float*)(ws + WS_TAB), (bf16*)(ws + WS_QROW), (bf16*)(ws + WS_KROW), (bf16*)(ws + WS_KDT), (bf16*)(ws + WS_GS), (bf16*)(ws + WS_PB),
               (bf16*)(ws + WS_ACAT), (bf16*)(ws + WS_BCAT)};
        pg8::gemm_phase(F.lds + RING_OFF, g, S, E);
    }
    SEAM(3);
    PHASE(4) { PHASE_ENV;
        {   const bf16* pbuf = (const bf16*)(ws + WS_PB); bf16* pooled = (bf16*)(ws + WS_POOLED);
            for (int t = gt; t < S_ * (PD / 8); t += NGT) { const int s = t >> 8, cv = t & 255, grp = cv >> 6; const int w = 2 << grp, wl = w >> 1;
                int st = s - wl; st = st < 0 ? 0 : st; int en = s + (w - 1 - wl) + 1; en = en > S_ ? S_ : en;
                float a[8];
#pragma unroll
                for (int j = 0; j < 8; ++j) a[j] = 0.f;
                for (int r = st; r < en; ++r) { const v4u pv = *(const v4u*)(pbuf + (size_t)r * PD + cv * 8);
                    a[0] += bf2f(pv.x & 0xffffu); a[1] += bf2f(pv.x >> 16); a[2] += bf2f(pv.y & 0xffffu); a[3] += bf2f(pv.y >> 16);
                    a[4] += bf2f(pv.z & 0xffffu); a[5] += bf2f(pv.z >> 16); a[6] += bf2f(pv.w & 0xffffu); a[7] += bf2f(pv.w >> 16); }
                const v4u sv = *(const v4u*)(pbuf + (size_t)s * PD + cv * 8); const float inv = 1.0f / (float)(en - st);
                v4u o; o.x = pk2(a[0] * inv - bf2f(sv.x & 0xffffu), a[1] * inv - bf2f(sv.x >> 16)); o.y = pk2(a[2] * inv - bf2f(sv.y & 0xffffu), a[3] * inv - bf2f(sv.y >> 16));
                o.z = pk2(a[4] * inv - bf2f(sv.z & 0xffffu), a[5] * inv - bf2f(sv.z >> 16)); o.w = pk2(a[6] * inv - bf2f(sv.w & 0xffffu), a[7] * inv - bf2f(sv.w >> 16));
                *(v4u*)(pooled + (size_t)s * PD + cv * 8) = o; }
            VM_WAIT(); __syncthreads();
        }
        {   pg8::Gemm g{(const bf16*)(ws + WS_BCAT), (const bf16*)(ws + WS_KDT), KCAT, S_, CH}; SchedKV S{F.G, (int)blockIdx.x};
            EpiKV E{(bf16*)(ws + WS_BCAT)};
            pg8::gemm_phase(F.lds + RING_OFF, g, S, E); }
        {   pg8::Gemm g{(const bf16*)(ws + WS_QROW), (const bf16*)(ws + WS_KROW), RD, RD, HD}; SchedS S{F.G, (int)blockIdx.x};
            EpiS E{(const float*)(ws + WS_TAB), (bf16*)(ws + WS_ACAT)};
            pg8::gemm_phase(F.lds + RING_OFF, g, S, E); }
    }
    SEAM(4);
    PHASE(5) { PHASE_ENV;
        if (!rep) {   bf16* bcat = (bf16*)(ws + WS_BCAT);
            for (int t = gt; t < 2 * NH * HD * (HD / 8); t += NGT) { const int dir = t >> 16, rem = t & 65535, h = rem >> 13, e = (rem >> 5) & 255, dv = rem & 31;
                const float l2 = ((const float*)(ws + WS_TAB))[dir * 8 + h]; const float dC = fast_exp2(l2 * (float)CH);
                bf16* p0 = bcat + ((size_t)(h * NCH) * 256 + e) * KCAT + 256 + 256 * dir + dv * 8; const size_t cstep = (size_t)256 * KCAT;
                float run[8];
#pragma unroll
                for (int j = 0; j < 8; ++j) run[j] = 0.f;
#pragma unroll 1
                for (int cb = 0; cb < NCH; cb += 8) { v4u kv[8];
#pragma unroll
                    for (int q = 0; q < 8; ++q) { const int c = dir ? (NCH - 1 - (cb + q)) : (cb + q); kv[q] = *(const v4u*)(p0 + (size_t)c * cstep); }
#pragma unroll
                    for (int q = 0; q < 8; ++q) { const int c = dir ? (NCH - 1 - (cb + q)) : (cb + q);
                        v4u o; o.x = pk2(run[0], run[1]); o.y = pk2(run[2], run[3]); o.z = pk2(run[4], run[5]); o.w = pk2(run[6], run[7]);
                        *(v4u*)(p0 + (size_t)c * cstep) = o;
                        run[0] = run[0] * dC + bf2f(kv[q].x & 0xffffu); run[1] = run[1] * dC + bf2f(kv[q].x >> 16); run[2] = run[2] * dC + bf2f(kv[q].y & 0xffffu); run[3] = run[3] * dC + bf2f(kv[q].y >> 16);
                        run[4] = run[4] * dC + bf2f(kv[q].z & 0xffffu); run[5] = run[5] * dC + bf2f(kv[q].z >> 16); run[6] = run[6] * dC + bf2f(kv[q].w & 0xffffu); run[7] = run[7] * dC + bf2f(kv[q].w >> 16); } } }
            VM_WAIT(); __syncthreads();
        }
        {   pg8::Gemm g{(const bf16*)(ws + WS_POOLED), (const bf16*)(ws + WS_WPOOL), PD, 512, 512}; SchedPool S{F.G, (int)blockIdx.x};
            EpiPool E{AIN(IN_PSCALE), (bf16*)(ws + WS_MIX)};
            pg8::gemm_phase(F.lds + RING_OFF, g, S, E); }
    }
    SEAM(5);
    PHASE(6) { PHASE_ENV;
        pg8::Gemm g{(const bf16*)(ws + WS_ACAT), (const bf16*)(ws + WS_BCAT), KCAT, KCAT, KCAT}; SchedOut S{F.G, (int)blockIdx.x};
        EpiOut E{AIN(IN_HNORM), (const bf16*)(ws + WS_GS), (bf16*)(ws + WS_MIX), (LAS float*)(F.lds + EPI_SCR_OFF)};
        pg8::gemm_phase(F.lds + RING_OFF, g, S, E);
    }
    SEAM(6);
    PHASE(7) { PHASE_ENV;
        pg8::Gemm g{(const bf16*)(ws + WS_MIX), (const bf16*)(ws + WS_WOUT), DM, DM, DM}; pg8::SchedGrid S; S.init(S_ / 256, DM / 256, F.G, (int)blockIdx.x, DM, DM);
        EpiResid E{rep ? (bf16*)(ws + WS_ACAT) : xb, rep ? dum_rs : rsq + 2 * S_, 1.0f};
        pg8::gemm_phase(F.lds + RING_OFF, g, S, E);
    }
    SEAM(7);
    PHASE(8) { PHASE_ENV;
        pg8::Gemm g{xb, (const bf16*)(ws + WS_WGU2), DM, DM, DM}; pg8::SchedGrid S; S.init(S_ / 256, 2 * FF / 256, F.G, (int)blockIdx.x, DM, DM);
        EpiGateUp E{rsq + 2 * S_, (bf16*)(ws + WS_ACT)};
        pg8::gemm_phase(F.lds + RING_OFF, g, S, E);
    }
    SEAM(8);
    PHASE(9) { PHASE_ENV;
        pg8::Gemm g{(const bf16*)(ws + WS_ACT), (const bf16*)(ws + WS_WD2), FF, FF, FF}; pg8::SchedGrid S; S.init(S_ / 256, DM / 256, F.G, (int)blockIdx.x, FF, FF);
        EpiResid E{rep ? (bf16*)(ws + WS_WGU1) : xb, rep ? dum_rs : rsq + 3 * S_, 0.5f};
        pg8::gemm_phase(F.lds + RING_OFF, g, S, E);
    }
    SEAM(9);
    PHASE(10) { PHASE_ENV;
        const float* fn = AIN(IN_FINN);
        const unsigned tmo = __hip_atomic_load((unsigned*)(ws + WS_CTL) + CW_BAR + XB_TMO, RLX_AGENT);
        for (int m = gw; m < S_; m += NGW) { float rs = 1.0f / sqrtf(rsq[3 * S_ + m] * (1.0f / DM) + EPS);
            if (tmo) rs = __builtin_nanf("");
            const v4u* xr = (const v4u*)(xb + (size_t)m * DM) + F.lane; f32x4* orow = (f32x4*)(xres + (size_t)m * DM);
#pragma unroll
            for (int j = 0; j < 8; ++j) { const v4u w = xr[64 * j]; accv a, b; unpack8(w, a, b);
                const f32x4 g0 = *((const f32x4*)fn + 2 * (F.lane + 64 * j)), g1 = *((const f32x4*)fn + 2 * (F.lane + 64 * j) + 1);
                orow[2 * (F.lane + 64 * j)] = a * rs * g0; orow[2 * (F.lane + 64 * j) + 1] = b * rs * g1; } }
    }
#undef IN
#undef SEAM
}

#ifndef MK_N_LAUNCHES
#define MK_N_LAUNCHES 1
#endif
extern "C" void kernel_launch(void* const* d_in, const int* in_sizes, int n_in, void* d_out, int out_size, void* d_ws, size_t ws_size, hipStream_t stream) {
    static int grid = 0;
    if (grid == 0) {
        if (n_in != 19 || in_sizes[0] != S_ * DM || out_size != S_ * DM || ws_size < WS_END2) { fprintf(stderr, "kernel_launch: unexpected shapes (n_in %d, in0 %d, out %d, ws %zu); nothing launched\n", n_in, n_in > 0 ? in_sizes[0] : -1, out_size, ws_size); grid = -1; return; }
        int dev = 0, cus = 0, per_cu = 0;
        if (hipGetDevice(&dev) != hipSuccess || hipDeviceGetAttribute(&cus, hipDeviceAttributeMultiprocessorCount, dev) != hipSuccess) { fprintf(stderr, "kernel_launch: device query failed\n"); grid = -1; return; }
        if (hipFuncSetAttribute((const void*)fwd_kernel, hipFuncAttributeMaxDynamicSharedMemorySize, LDS_BYTES) != hipSuccess) { fprintf(stderr, "kernel_launch: hipFuncSetAttribute failed\n"); grid = -1; return; }
        if (hipOccupancyMaxActiveBlocksPerMultiprocessor(&per_cu, (const void*)fwd_kernel, NWAVES * 64, LDS_BYTES) != hipSuccess || per_cu < 1) { fprintf(stderr, "kernel_launch: occupancy query reports %d workgroups per CU\n", per_cu); per_cu = 1; }
        (void)hipGetLastError();
        grid = cus;
    }
    if (grid < 0) return;
    if (hipMemsetAsync((char*)d_ws + WS_CTL, 0, CTL_ZERO_BYTES, stream) != hipSuccess) { fprintf(stderr, "kernel_launch: memset failed\n"); return; }
    Args a{};
    for (int i = 0; i < 19; ++i) a.in[i] = (const float*)d_in[i];
    a.pos = (const int*)d_in[IN_POS]; a.out = (float*)d_out; a.ws = (unsigned char*)d_ws;
#if MK_N_LAUNCHES == 1
    a.ph_lo = 0; a.ph_hi = NPHASE;
    hipLaunchKernelGGL(fwd_kernel, dim3(grid), dim3(NWAVES * 64), LDS_BYTES, stream, a);
#else
    for (int p = 0; p < NPHASE; ++p) { a.ph_lo = p; a.ph_hi = p + 1; hipLaunchKernelGGL(fwd_kernel, dim3(grid), dim3(NWAVES * 64), LDS_BYTES, stream, a); }
#endif
    const hipError_t le = hipPeekAtLastError();
    if (le != hipSuccess) fprintf(stderr, "kernel_launch: launch failed: %s\n", hipGetErrorName(le));
}
```

```cpp
#include <hip/hip_runtime.h>
#include <cstdio>
#include <cstdint>

namespace pg8 {
#define PG8_LAS __attribute__((address_space(3)))
typedef unsigned short bf16_t;
typedef short bf16x8 __attribute__((ext_vector_type(8)));
typedef float f32x4 __attribute__((ext_vector_type(4)));
typedef unsigned u32x4 __attribute__((ext_vector_type(4)));
constexpr int BM = 256, BK = 64, HALF = 128, HTB = HALF * BK * 2  , STAGE_BYTES = 8 * HTB, NXCD = 8, WGM = 8;

__host__ __device__ __forceinline__ int lds_byte(int r, int c) { const int st = (r >> 4) * 2 + (c >> 5), rr = r & 15, cc = c & 31, ob = rr * 64 + cc * 2; return st * 1024 + (ob ^ (((ob >> 9) & 1) << 5)); }
__host__ __device__ __forceinline__ void stage_rc(int b, int& R, int& C) { const int st = b / 1024, sb = b % 1024, swz = sb ^ (((sb >> 9) & 1) << 5); R = (st >> 1) * 16 + swz / 64; C = (st & 1) * 32 + (swz % 64) / 2; }
__host__ __device__ __forceinline__ int perm32(int rho) { const int n = rho >> 4, i = rho & 15; return 8 * (i >> 2) + 4 * n + (i & 3); }

struct Unit { int pm, pn, z; };
struct Gemm { const bf16_t* A; const bf16_t* Bt; int lda, ldb, K; };

struct SchedGrid {
    int nM, nN, nwg, G, c; size_t astep, bstep;
    __device__ __forceinline__ void init(int nM_, int nN_, int G_, int c_, int lda, int ldb) { nM = nM_; nN = nN_; nwg = nM * nN; G = G_; c = c_; astep = (size_t)BM * lda * 2; bstep = (size_t)BM * ldb * 2; }
    __device__ __forceinline__ bool next(int i, Unit& u) const {
        const long L = (long)i * G + c; if (L >= nwg) return false;
        int wgid = (int)L; { const int q = nwg / NXCD, r = nwg % NXCD, xcd = wgid % NXCD, off = wgid / NXCD; wgid = (xcd < r ? xcd * (q + 1) : r * (q + 1) + (xcd - r) * q) + off; }
        const int nig = WGM * nN, gid = wgid / nig, fm = gid * WGM, gsz = (nM - fm) < WGM ? (nM - fm) : WGM;
        u.pm = fm + ((wgid % nig) % gsz); u.pn = (wgid % nig) / gsz; u.z = 0; return true;
    }
    __device__ __forceinline__ size_t a_off(const Unit& u) const { return (size_t)u.pm * astep; }
    __device__ __forceinline__ size_t b_off(const Unit& u) const { return (size_t)u.pn * bstep; }
};

__device__ __forceinline__ unsigned cvt_pk_bf16(float lo, float hi) { unsigned r; asm volatile("v_cvt_pk_bf16_f32 %0, %1, %2" : "=v"(r) : "v"(lo), "v"(hi)); return r; }

template <class Epi, class Sched>
__device__ __forceinline__ void gemm_phase(PG8_LAS unsigned char* lds, const Gemm g, const Sched& S, const Epi& E) {
    const int tid = threadIdx.x, wid = __builtin_amdgcn_readfirstlane(tid >> 6), lane = tid & 63, wr = wid >> 2, wc = wid & 3, fr = lane & 15, fq = lane >> 4;
    int nt = g.K / BK; asm volatile("" : "+s"(nt));
    unsigned voffA[2], voffB[2];
#pragma unroll
    for (int i = 0; i < 2; ++i) { int R, C; stage_rc(tid * 16 + i * 8192, R, C); const int Rb = (R & ~31) + perm32(R & 31);
        voffA[i] = (unsigned)(R * g.lda + C) * 2u; voffB[i] = (unsigned)(Rb * g.ldb + C) * 2u; }
    const size_t kstep = (size_t)(BK * 2);
    const size_t hstepA = (size_t)HALF * g.lda * 2, hstepB = (size_t)HALF * g.ldb * 2;
    const unsigned ldsw = (unsigned)wid * 1024u;
    const int aoff = lds_byte(wr * 64 + fr, fq * 8), boff = lds_byte(wc * 32 + fr, fq * 8);
#define PG8_SA(b, h) (((b) * 2 + (h)) * HTB)
#define PG8_SB(b, h) ((4 + (b) * 2 + (h)) * HTB)
#define PG8_STAGE(bufoff, gbase, voff) do { _Pragma("unroll") for (int _i = 0; _i < 2; ++_i) \
        __builtin_amdgcn_global_load_lds((const unsigned*)((const char*)(gbase) + (voff)[_i]), (PG8_LAS unsigned*)(lds + (bufoff) + ldsw + _i * 8192), 16, 0, 0); } while (0)
#define PG8_LDA(dst, b, h) do { _Pragma("unroll") for (int m = 0; m < 4; ++m) _Pragma("unroll") for (int k = 0; k < 2; ++k) dst[m][k] = *(const PG8_LAS bf16x8*)(lds + PG8_SA(b, h) + aoff + m * 2048 + k * 1024); } while (0)
#define PG8_LDB(dst, b, h) do { _Pragma("unroll") for (int n = 0; n < 2; ++n) _Pragma("unroll") for (int k = 0; k < 2; ++k) dst[n][k] = *(const PG8_LAS bf16x8*)(lds + PG8_SB(b, h) + boff + n * 2048 + k * 1024); } while (0)
#define PG8_MMA(ai, bj, At, Bt) do { __builtin_amdgcn_s_setprio(1); _Pragma("unroll") for (int m = 0; m < 4; ++m) _Pragma("unroll") for (int n = 0; n < 2; ++n) _Pragma("unroll") for (int k = 0; k < 2; ++k) \
        acc[ai][bj][m][n] = __builtin_amdgcn_mfma_f32_16x16x32_bf16(Bt[n][k], At[m][k], acc[ai][bj][m][n], 0, 0, 0); __builtin_amdgcn_s_setprio(0); } while (0)
#define PG8_WAIT_V(n) asm volatile("s_waitcnt vmcnt(" #n ")" ::: "memory")
#define PG8_WAIT_L(n) asm volatile("s_waitcnt lgkmcnt(" #n ")" ::: "memory")
#define PG8_BAR __builtin_amdgcn_s_barrier()
#define PG8_SCHED __builtin_amdgcn_sched_barrier(0)
    Unit cur, nxt; int ui = 0;
    if (!S.next(0, cur)) return;
    f32x4 acc[2][2][4][2];
#pragma unroll
    for (int a = 0; a < 2; ++a)
#pragma unroll
        for (int b = 0; b < 2; ++b)
#pragma unroll
            for (int m = 0; m < 4; ++m)
#pragma unroll
                for (int n = 0; n < 2; ++n) acc[a][b][m][n] = (f32x4){0.f, 0.f, 0.f, 0.f};
    bf16x8 At[4][2], B0[2][2], B1[2][2];
    const char* cA = (const char*)g.A + S.a_off(cur); const char* cB = (const char*)g.Bt + S.b_off(cur);
    PG8_STAGE(PG8_SB(0, 0), cB, voffB); PG8_STAGE(PG8_SB(0, 1), cB + hstepB, voffB); PG8_STAGE(PG8_SA(0, 0), cA, voffA); PG8_STAGE(PG8_SA(0, 1), cA + hstepA, voffA);
    if (wr == 1) PG8_BAR;
    PG8_WAIT_V(2); PG8_BAR;
    PG8_STAGE(PG8_SB(1, 0), cB + kstep, voffB); PG8_STAGE(PG8_SA(1, 0), cA + kstep, voffA); PG8_STAGE(PG8_SB(1, 1), cB + hstepB + kstep, voffB);
    PG8_WAIT_V(6); PG8_BAR;
    for (;;) {
        const bool has_next = S.next(ui + 1, nxt);
        const char* nA = has_next ? (const char*)g.A + S.a_off(nxt) : cA; const char* nB = has_next ? (const char*)g.Bt + S.b_off(nxt) : cB;
        for (int t = 0; t < nt; t += 2) {
            const bool last = (t == nt - 2);
            const char* a1 = cA + (size_t)(t + 1) * kstep;
            const char* a2 = last ? nA : cA + (size_t)(t + 2) * kstep; const char* b2 = last ? nB : cB + (size_t)(t + 2) * kstep;
            const char* a3 = a2 + kstep; const char* b3 = b2 + kstep;
            PG8_LDB(B0, 0, 0); PG8_LDB(B1, 0, 1); PG8_SCHED; PG8_LDA(At, 0, 0); PG8_STAGE(PG8_SA(1, 1), a1 + hstepA, voffA);
            PG8_WAIT_V(8); PG8_WAIT_L(0); PG8_BAR; PG8_MMA(0, 0, At, B0); PG8_MMA(0, 1, At, B1); PG8_BAR; PG8_SCHED;
            PG8_LDA(At, 0, 1); PG8_STAGE(PG8_SB(0, 0), b2, voffB); PG8_STAGE(PG8_SB(0, 1), b2 + hstepB, voffB); PG8_STAGE(PG8_SA(0, 0), a2, voffA);
            PG8_WAIT_V(8); PG8_WAIT_L(0); PG8_BAR; PG8_MMA(1, 0, At, B0); PG8_MMA(1, 1, At, B1); PG8_BAR; PG8_SCHED;
            PG8_LDB(B0, 1, 0); PG8_LDB(B1, 1, 1); PG8_SCHED; PG8_LDA(At, 1, 0); PG8_STAGE(PG8_SA(0, 1), a2 + hstepA, voffA);
            PG8_WAIT_V(8); PG8_WAIT_L(0); PG8_BAR; PG8_MMA(0, 0, At, B0); PG8_MMA(0, 1, At, B1); PG8_BAR; PG8_SCHED;
            PG8_LDA(At, 1, 1); PG8_STAGE(PG8_SB(1, 0), b3, voffB); PG8_STAGE(PG8_SB(1, 1), b3 + hstepB, voffB); PG8_STAGE(PG8_SA(1, 0), a3, voffA);
            PG8_WAIT_V(8); PG8_WAIT_L(0); PG8_BAR; PG8_MMA(1, 0, At, B0); PG8_MMA(1, 1, At, B1); PG8_BAR; PG8_SCHED;
        }
        if (wr == 0) PG8_BAR;
        { int fr2 = fr, fq2 = fq; asm volatile("" : "+v"(fr2), "+v"(fq2));
          E(acc, cur, wr, wc, fr2, fq2); }
        if (!has_next) break;
#pragma unroll
        for (int a = 0; a < 2; ++a)
#pragma unroll
            for (int b = 0; b < 2; ++b)
#pragma unroll
                for (int m = 0; m < 4; ++m)
#pragma unroll
                    for (int n = 0; n < 2; ++n) acc[a][b][m][n] = (f32x4){0.f, 0.f, 0.f, 0.f};
        cur = nxt; cA = nA; cB = nB; ++ui;
        if (wr == 1) PG8_BAR;
    }
    PG8_WAIT_V(0);
    PG8_BAR;
#undef PG8_SA
#undef PG8_SB
#undef PG8_STAGE
#undef PG8_LDA
#undef PG8_LDB
#undef PG8_MMA
#undef PG8_WAIT_V
#undef PG8_WAIT_L
#undef PG8_BAR
#undef PG8_SCHED
}
}

constexpr int NWAVES = 8;
constexpr int S_ = 16384, DM = 4096, FF = 11008, PROJ = 10240, RD = 2048, NH = 8, HD = 256, CH = 256, NCH = S_ / CH, PD = 2048;
constexpr float EPS = 1e-6f;
constexpr int KCAT = 768;

constexpr size_t MiB = 1u << 20;
constexpr size_t WS_CTL = 0, CTL_ZERO_BYTES = 1 * MiB;
constexpr size_t WS_TAB = 1 * MiB;
constexpr size_t WS_CS = 2 * MiB;
constexpr size_t WS_WPOOL = 18 * MiB;
constexpr size_t WS_WIN = 20 * MiB, WS_WOUT = 100 * MiB, WS_WGU2 = 132 * MiB, WS_WD2 = 304 * MiB;
constexpr size_t WS_XB = 390 * MiB;
constexpr size_t WS_WGU1 = 518 * MiB, WS_WD1 = 690 * MiB, WS_ACT = 776 * MiB;
constexpr size_t WS_QROW = 518 * MiB, WS_KROW = 582 * MiB, WS_KDT = 646 * MiB  , WS_GS = 774 * MiB, WS_PB = 838 * MiB, WS_POOLED = 902 * MiB;
constexpr size_t WS_ACAT = 966 * MiB, WS_BCAT = 1158 * MiB, WS_END = 1350 * MiB;
constexpr size_t WS_MIX = 1350 * MiB, WS_END2 = 1478 * MiB;
static_assert(WS_WIN + (size_t)PROJ * DM * 2 <= WS_WOUT && WS_WOUT + (size_t)DM * DM * 2 <= WS_WGU2 && WS_WGU2 + (size_t)2 * FF * DM * 2 <= WS_WD2 && WS_WD2 + (size_t)DM * FF * 2 <= WS_XB, "weights map");
static_assert(WS_XB + (size_t)S_ * DM * 2 <= WS_WGU1 && WS_WGU1 + (size_t)2 * FF * DM * 2 <= WS_WD1 && WS_WD1 + (size_t)DM * FF * 2 <= WS_ACT && WS_ACT + (size_t)S_ * FF * 2 <= WS_END, "ffn map");
static_assert(WS_ACAT + (size_t)NH * S_ * KCAT * 2 <= WS_BCAT && WS_BCAT + (size_t)NH * NCH * HD * KCAT * 2 <= WS_END && WS_POOLED + (size_t)S_ * PD * 2 <= WS_ACAT, "mixer map");
constexpr int CW_BAR = 4096;
constexpr int CW_RSQ = 16384;

constexpr int RING_OFF = 0, RING_BYTES = 131072;
constexpr int LDS_BYTES = 147456;
constexpr int EPI_SCR_OFF = 135168;
constexpr int MISC_OFF = LDS_BYTES - 256;
constexpr int TR_LD = 65, TR_BYTES = 64 * TR_LD * 4;
static_assert(NWAVES * TR_BYTES <= EPI_SCR_OFF + 4096 && EPI_SCR_OFF + 4096 <= MISC_OFF, "LDS map");

#define GAS __attribute__((address_space(1)))
#define LAS __attribute__((address_space(3)))
typedef unsigned short bf16;
typedef unsigned v4u __attribute__((ext_vector_type(4)));
typedef unsigned v2u __attribute__((ext_vector_type(2)));
typedef float f32x4 __attribute__((ext_vector_type(4)));
typedef GAS unsigned gu32;
#define RLX_AGENT __ATOMIC_RELAXED, __HIP_MEMORY_SCOPE_AGENT
#define LDS_WAIT() asm volatile("s_waitcnt lgkmcnt(0)" ::: "memory")
#define VM_WAIT() asm volatile("s_waitcnt vmcnt(0)" ::: "memory")
__device__ __forceinline__ unsigned f2bf(float f) { unsigned u = __builtin_bit_cast(unsigned, f); return (u + 0x7fffu + ((u >> 16) & 1u)) >> 16; }
typedef __bf16 bf16x2_t __attribute__((ext_vector_type(2)));
typedef float f32x2_t __attribute__((ext_vector_type(2)));
__device__ __forceinline__ unsigned pk2t(float lo, float hi) { const f32x2_t v = {lo, hi}; return __builtin_bit_cast(unsigned, __builtin_convertvector(v, bf16x2_t)); }
__device__ __forceinline__ unsigned pk2(float lo, float hi) { return pg8::cvt_pk_bf16(lo, hi); }
__device__ __forceinline__ float bf2f(unsigned h) { return __builtin_bit_cast(float, h << 16); }
__device__ __forceinline__ float fast_exp2(float x) { return __builtin_amdgcn_exp2f(x); }
__device__ __forceinline__ float silu_f(float x) { return x * __builtin_amdgcn_rcpf(1.0f + fast_exp2(-1.4426950408889634f * x)); }
__device__ __forceinline__ float log2_sigmoid(float x) { return -log1pf(expf(-x)) * 1.4426950408889634f; }

#define XB_TMO      128
#define XB_XCNT(j)  (256  + 64 * (j))
#define XB_XSUB(j)  (1280 + 64 * (j))
#define XB_XGEN(j)  (2304 + 64 * (j))
#define XB_TOP      3328
#define XB_TOPGEN   3392
#define XCD_BAR_WORDS 3456
#define XB_SPIN_CAP (1u << 18)

__device__ __forceinline__ unsigned xb_ld(unsigned* p)              { return __hip_atomic_load(p, __ATOMIC_RELAXED, __HIP_MEMORY_SCOPE_AGENT); }
__device__ __forceinline__ unsigned xb_add(unsigned* p, unsigned v) { return __hip_atomic_fetch_add(p, v, __ATOMIC_RELAXED, __HIP_MEMORY_SCOPE_AGENT); }
__device__ __forceinline__ unsigned xb_xcc_id() { return (unsigned)__builtin_amdgcn_s_getreg((3 << 11) | 20) & 0xFu; }
#define XB_SPIN(cond, bar) do { unsigned _sp = 0; while (cond) { __builtin_amdgcn_s_sleep(1); \
    if ((++_sp & 255u) == 0u) { if (xb_ld(&(bar)[XB_TMO])) break; if (_sp > XB_SPIN_CAP) { atomicAdd(&(bar)[XB_TMO], 1u); break; } } } } while (0)

struct XcdBarrier {
    unsigned* bar; unsigned x;
    volatile LAS unsigned* st;
};
__device__ __forceinline__ XcdBarrier xcd_barrier_post(unsigned* bar, volatile LAS unsigned* st) {
    XcdBarrier b; b.bar = bar; b.x = xb_xcc_id(); b.st = st;
    if (threadIdx.x == 0) (void)xb_add(&bar[XB_XCNT(b.x)], 1u);
    return b;
}
__device__ __forceinline__ void xcd_barrier_complete(unsigned* bar, unsigned x, unsigned& nloc, unsigned& nx) {
    const unsigned G = gridDim.x * gridDim.y * gridDim.z;
    unsigned sum, cnt, mine, sp = 0u;
    for (;;) {
        sum = 0u; cnt = 0u; mine = 0u;
#pragma unroll
        for (unsigned j = 0; j < 16; ++j) { const unsigned c = xb_ld(&bar[XB_XCNT(j)]); sum += c; cnt += (c > 0u) ? 1u : 0u; mine = (j == x) ? c : mine; }
        if (sum == G) break;
        __builtin_amdgcn_s_sleep(1);
        if ((++sp & 255u) == 0u) { if (xb_ld(&bar[XB_TMO])) break; if (sp > XB_SPIN_CAP) { atomicAdd(&bar[XB_TMO], 1u); break; } }
    }
    nloc = mine > 0u ? mine : 1u; nx = cnt > 0u ? cnt : 1u;
}
__device__ __forceinline__ void xcd_barrier(const XcdBarrier& b) {
    asm volatile("s_waitcnt vmcnt(0)" ::: "memory");
    __syncthreads();
    if (threadIdx.x == 0) {
        unsigned* bar = b.bar;
        __builtin_amdgcn_s_waitcnt(0);
        unsigned nloc = b.st[0], nx = b.st[1];
        if (nloc == 0u) { xcd_barrier_complete(bar, b.x, nloc, nx); b.st[0] = nloc; b.st[1] = nx; }
        const unsigned old = xb_add(&bar[XB_XSUB(b.x)], 1u);
        const unsigned gen = old / nloc;
        if (old + 1u == (gen + 1u) * nloc) {
            __builtin_amdgcn_fence(__ATOMIC_RELEASE, "agent");
            asm volatile("s_waitcnt vmcnt(0)" ::: "memory");
            const unsigned og = xb_add(&bar[XB_TOP], 1u);
            const unsigned tg = og / nx;
            if (og + 1u == (tg + 1u) * nx) xb_add(&bar[XB_TOPGEN], 1u);
            else XB_SPIN(xb_ld(&bar[XB_TOPGEN]) == tg, bar);
            __builtin_amdgcn_fence(__ATOMIC_ACQUIRE, "agent");
            xb_add(&bar[XB_XGEN(b.x)], 1u);
            asm volatile("s_waitcnt vmcnt(0)" ::: "memory");
        } else {
            XB_SPIN(xb_ld(&bar[XB_XGEN(b.x)]) == gen, bar);
            __builtin_amdgcn_fence(__ATOMIC_ACQUIRE, "agent");
            asm volatile("s_waitcnt vmcnt(0)" ::: "memory");
        }
    }
    __syncthreads();
}

using pg8::Unit;
typedef pg8::f32x4 accv;

__device__ __forceinline__ v4u pack8(const accv& v0, const accv& v1) { v4u w; w.x = pk2(v0[0], v0[1]); w.y = pk2(v0[2], v0[3]); w.z = pk2(v1[0], v1[1]); w.w = pk2(v1[2], v1[3]); return w; }

struct EpiGateUp {
    static constexpr bool PERM = true;
    const float* rowsq; bf16* act;
    __device__ __forceinline__ void operator()(const accv (&acc)[2][2][4][2], const Unit& u, int wr, int wc, int fr, int fq) const {
        const int row0 = u.pm * 256 + wr * 64 + fr, col0 = u.pn * 128 + wc * 32 + 8 * fq;
#pragma unroll
        for (int ai = 0; ai < 2; ++ai)
#pragma unroll
            for (int m = 0; m < 4; ++m) { const int row = row0 + ai * 128 + m * 16; const float rs = 1.0f / sqrtf(rowsq[row] * (1.0f / DM) + EPS);
                accv o[2];
#pragma unroll
                for (int n = 0; n < 2; ++n)
#pragma unroll
                    for (int j = 0; j < 4; ++j) { const float g = acc[ai][0][m][n][j] * rs, up = acc[ai][1][m][n][j] * rs; o[n][j] = silu_f(g) * up; }
                *(v4u*)(act + (size_t)row * FF + col0) = pack8(o[0], o[1]); }
    }
};

__device__ __forceinline__ void unpack8(const v4u& w, accv& a, accv& b) { a[0] = bf2f(w.x & 0xffffu); a[1] = bf2f(w.x >> 16); a[2] = bf2f(w.y & 0xffffu); a[3] = bf2f(w.y >> 16);
    b[0] = bf2f(w.z & 0xffffu); b[1] = bf2f(w.z >> 16); b[2] = bf2f(w.w & 0xffffu); b[3] = bf2f(w.w >> 16); }
struct EpiResid {
    static constexpr bool PERM = true;
    bf16* xs; float* rowsq; float scale;
    __device__ __forceinline__ void operator()(const accv (&acc)[2][2][4][2], const Unit& u, int wr, int wc, int fr, int fq) const {
        const int row0 = u.pm * 256 + wr * 64 + fr, col0 = u.pn * 256 + wc * 32 + 8 * fq;
        v4u xo[2][4][2];
#pragma unroll
        for (int ai = 0; ai < 2; ++ai)
#pragma unroll
            for (int m = 0; m < 4; ++m)
#pragma unroll
                for (int bj = 0; bj < 2; ++bj) xo[ai][m][bj] = *(const v4u*)(xs + (size_t)(row0 + ai * 128 + m * 16) * DM + col0 + bj * 128);
        asm volatile("" ::: "memory");
#pragma unroll
        for (int ai = 0; ai < 2; ++ai)
#pragma unroll
            for (int m = 0; m < 4; ++m) { const int row = row0 + ai * 128 + m * 16; const size_t off = (size_t)row * DM + col0; float ss = 0.f;
#pragma unroll
                for (int bj = 0; bj < 2; ++bj) { accv v0, v1; unpack8(xo[ai][m][bj], v0, v1);
                    v0 = v0 + acc[ai][bj][m][0] * scale; v1 = v1 + acc[ai][bj][m][1] * scale;
                    ss += (v0[0] * v0[0] + v0[1] * v0[1]) + (v0[2] * v0[2] + v0[3] * v0[3]) + (v1[0] * v1[0] + v1[1] * v1[1]) + (v1[2] * v1[2] + v1[3] * v1[3]);
                    *(v4u*)(xs + off + bj * 128) = pack8(v0, v1); }
                ss += __shfl_xor(ss, 16); ss += __shfl_xor(ss, 32);
                if (fq == 0) atomicAdd(rowsq + row, ss); }
    }
};

struct EpiZ {
    static constexpr bool PERM = true;
    const float* rowsq; const float* cs; const float* l2tab;
    bf16 *qrow, *krow, *kdt, *gs, *pb, *acat, *bcat;
    __device__ __forceinline__ void operator()(const accv (&acc)[2][2][4][2], const Unit& u, int wr, int wc, int fr, int fq) const {
        const int type = u.pn >> 3, h = u.pn & 7, c = u.pm;
        const int i0 = wr * 64 + fr, d1 = wc * 32 + 8 * fq;
        if (type <= 1) {
            const float l2a = l2tab[h], l2b = l2tab[8 + h];
#pragma unroll
            for (int ai = 0; ai < 2; ++ai)
#pragma unroll
                for (int m = 0; m < 4; ++m) { const int i = i0 + ai * 128 + m * 16, s = c * 256 + i;
                    const float rs = 1.0f / sqrtf(rowsq[s] * (1.0f / DM) + EPS);
                    const accv c0 = *(const accv*)(cs + (size_t)s * 128 + d1), c1 = *(const accv*)(cs + (size_t)s * 128 + d1 + 4);
                    const accv s0 = *(const accv*)(cs + (size_t)S_ * 128 + (size_t)s * 128 + d1), s1 = *(const accv*)(cs + (size_t)S_ * 128 + (size_t)s * 128 + d1 + 4);
                    accv r1[2], r2[2];
                    r1[0] = acc[ai][0][m][0] * c0 - acc[ai][1][m][0] * s0; r1[1] = acc[ai][0][m][1] * c1 - acc[ai][1][m][1] * s1;
                    r2[0] = acc[ai][0][m][0] * s0 + acc[ai][1][m][0] * c0; r2[1] = acc[ai][0][m][1] * s1 + acc[ai][1][m][1] * c1;
                    if (type == 0) {
                        const size_t o = (size_t)s * RD + h * 256 + d1;
                        *(v4u*)(qrow + o) = pack8(r1[0] * rs, r1[1] * rs); *(v4u*)(qrow + o + 128) = pack8(r2[0] * rs, r2[1] * rs);
                        const float sf = rs * fast_exp2(l2a * (float)(i + 1)), sb = rs * fast_exp2(l2b * (float)(CH - i));
                        const size_t oa = ((size_t)h * S_ + s) * KCAT + 256 + d1;
                        *(v4u*)(acat + oa) = pack8(r1[0] * sf, r1[1] * sf); *(v4u*)(acat + oa + 128) = pack8(r2[0] * sf, r2[1] * sf);
                        *(v4u*)(acat + oa + 256) = pack8(r1[0] * sb, r1[1] * sb); *(v4u*)(acat + oa + 384) = pack8(r2[0] * sb, r2[1] * sb);
                    } else {
                        const float rk = rs * 0.0625f;
                        const size_t o = (size_t)s * RD + h * 256 + d1;
                        *(v4u*)(krow + o) = pack8(r1[0] * rk, r1[1] * rk); *(v4u*)(krow + o + 128) = pack8(r2[0] * rk, r2[1] * rk);
                        const float sf = rk * fast_exp2(l2a * (float)(CH - 1 - i)), sb = rk * fast_exp2(l2b * (float)i);
                        bf16* tf = kdt + ((size_t)h * 256 + d1) * S_ + s; bf16* tb = tf + (size_t)RD * S_;
#pragma unroll
                        for (int n = 0; n < 2; ++n)
#pragma unroll
                            for (int j = 0; j < 4; ++j) { const size_t t = (size_t)(4 * n + j) * S_;
                                tf[t] = (bf16)f2bf(r1[n][j] * sf); tf[t + (size_t)128 * S_] = (bf16)f2bf(r2[n][j] * sf);
                                tb[t] = (bf16)f2bf(r1[n][j] * sb); tb[t + (size_t)128 * S_] = (bf16)f2bf(r2[n][j] * sb); }
                    }
                    asm volatile("" ::: "memory"); }
        } else if (type == 2) {
            bf16* base = bcat + ((size_t)(h * NCH + c) * 256) * KCAT;
#pragma unroll
            for (int ai = 0; ai < 2; ++ai)
#pragma unroll
                for (int m = 0; m < 4; ++m) { const int i = i0 + ai * 128 + m * 16, s = c * 256 + i;
                    const float rs = 1.0f / sqrtf(rowsq[s] * (1.0f / DM) + EPS);
#pragma unroll
                    for (int bj = 0; bj < 2; ++bj)
#pragma unroll
                        for (int n = 0; n < 2; ++n)
#pragma unroll
                            for (int j = 0; j < 4; ++j) base[(size_t)(bj * 128 + d1 + 4 * n + j) * KCAT + i] = (bf16)f2bf(acc[ai][bj][m][n][j] * rs); }
        } else {
            bf16* dst = (type == 3) ? gs : pb;
#pragma unroll
            for (int ai = 0; ai < 2; ++ai)
#pragma unroll
                for (int m = 0; m < 4; ++m) { const int i = i0 + ai * 128 + m * 16, s = c * 256 + i;
                    const float rs = 1.0f / sqrtf(rowsq[s] * (1.0f / DM) + EPS);
#pragma unroll
                    for (int bj = 0; bj < 2; ++bj) { accv v0 = acc[ai][bj][m][0] * rs, v1 = acc[ai][bj][m][1] * rs;
                        if (type == 3) {
#pragma unroll
                            for (int j = 0; j < 4; ++j) { v0[j] = silu_f(v0[j]); v1[j] = silu_f(v1[j]); } }
                        *(v4u*)(dst + (size_t)s * RD + h * 256 + bj * 128 + d1) = pack8(v0, v1); } }
        }
    }
};

struct EpiKV {
    static constexpr bool PERM = true;
    bf16* bcat;
    __device__ __forceinline__ void operator()(const accv (&acc)[2][2][4][2], const Unit& u, int wr, int wc, int fr, int fq) const {
        bf16* base = bcat + ((size_t)(u.pn * NCH + u.pm) * 256) * KCAT + 256 + 256 * u.z + wc * 32 + 8 * fq;
        const int r0 = wr * 64 + fr;
#pragma unroll
        for (int ai = 0; ai < 2; ++ai)
#pragma unroll
            for (int m = 0; m < 4; ++m) { bf16* rp = base + (size_t)(r0 + ai * 128 + m * 16) * KCAT;
#pragma unroll
                for (int bj = 0; bj < 2; ++bj) *(v4u*)(rp + bj * 128) = pack8(acc[ai][bj][m][0], acc[ai][bj][m][1]); }
    }
};

struct EpiS {
    static constexpr bool PERM = true;
    const float* l2tab; bf16* acat;
    __device__ __forceinline__ void operator()(const accv (&acc)[2][2][4][2], const Unit& u, int wr, int wc, int fr, int fq) const {
        const int h = u.pn, c = u.pm;
        float l2a = l2tab[h], l2b = l2tab[8 + h];
        const int i0 = wr * 64 + fr, j0 = wc * 32 + 8 * fq;
        bf16* base = acat + ((size_t)h * S_ + (size_t)c * 256) * KCAT + j0;
#pragma unroll
        for (int ai = 0; ai < 2; ++ai)
#pragma unroll
            for (int m = 0; m < 4; ++m) { const int i = i0 + ai * 128 + m * 16;
#pragma unroll
                for (int bj = 0; bj < 2; ++bj) { accv v[2];
#pragma unroll
                    for (int n = 0; n < 2; ++n)
#pragma unroll
                        for (int j = 0; j < 4; ++j) { const float dd = (float)(i - (bj * 128 + j0 + 4 * n + j)); const float e = l2a * fmaxf(dd, 0.f) - l2b * fminf(dd, 0.f); v[n][j] = acc[ai][bj][m][n][j] * fast_exp2(e); }
                    *(v4u*)(base + (size_t)i * KCAT + bj * 128) = pack8(v[0], v[1]); }
                asm volatile("" : "+v"(l2a), "+v"(l2b) :: "memory"); }
    }
};

struct EpiPool {
    static constexpr bool PERM = true;
    const float* pscale; bf16* mix;
    __device__ __forceinline__ void operator()(const accv (&acc)[2][2][4][2], const Unit& u, int wr, int wc, int fr, int fq) const {
        const int row0 = u.pm * 256 + wr * 64 + fr, colp = u.pn * 256 + wc * 32 + 8 * fq;
        accv sc[2][2];
#pragma unroll
        for (int bj = 0; bj < 2; ++bj)
#pragma unroll
            for (int n = 0; n < 2; ++n) sc[bj][n] = *(const accv*)(pscale + colp + bj * 128 + 4 * n);
#pragma unroll
        for (int ai = 0; ai < 2; ++ai)
#pragma unroll
            for (int m = 0; m < 4; ++m) { bf16* rp = mix + (size_t)(row0 + ai * 128 + m * 16) * DM + RD + colp;
#pragma unroll
                for (int bj = 0; bj < 2; ++bj) *(v4u*)(rp + bj * 128) = pack8(acc[ai][bj][m][0] * sc[bj][0], acc[ai][bj][m][1] * sc[bj][1]); }
    }
};

struct EpiOut {
    static constexpr bool PERM = true;
    const float* hnorm; const bf16* gs; bf16* mix; LAS float* scr;
    __device__ __forceinline__ void operator()(const accv (&acc)[2][2][4][2], const Unit& u, int wr, int wc, int fr, int fq) const {
        const int h = u.pn, c = u.pm; const int i0 = wr * 64 + fr, e0 = wc * 32 + 8 * fq;
#pragma unroll
        for (int ai = 0; ai < 2; ++ai)
#pragma unroll
            for (int m = 0; m < 4; ++m) { float ss = 0.f;
#pragma unroll
                for (int bj = 0; bj < 2; ++bj)
#pragma unroll
                    for (int n = 0; n < 2; ++n) { const accv x = acc[ai][bj][m][n]; ss += (x[0] * x[0] + x[1] * x[1]) + (x[2] * x[2] + x[3] * x[3]); }
                ss += __shfl_xor(ss, 16); ss += __shfl_xor(ss, 32);
                if (fq == 0) scr[(i0 + ai * 128 + m * 16) * 4 + wc] = ss; }
        asm volatile("s_waitcnt lgkmcnt(0)" ::: "memory"); __builtin_amdgcn_s_barrier(); asm volatile("" ::: "memory");
        accv hn[2][2];
#pragma unroll
        for (int bj = 0; bj < 2; ++bj)
#pragma unroll
            for (int n = 0; n < 2; ++n) hn[bj][n] = *(const accv*)(hnorm + h * 256 + bj * 128 + e0 + 4 * n);
#pragma unroll
        for (int ai = 0; ai < 2; ++ai)
#pragma unroll
            for (int m = 0; m < 4; ++m) { const int i = i0 + ai * 128 + m * 16; const accv p = *(const LAS accv*)(scr + i * 4);
                const float rn = 1.0f / sqrtf(((p[0] + p[1]) + (p[2] + p[3])) * (1.0f / HD) + EPS);
                const size_t o = (size_t)(c * 256 + i) * RD + h * 256 + e0;
#pragma unroll
                for (int bj = 0; bj < 2; ++bj) { const v4u gv = *(const v4u*)(gs + o + bj * 128);
                    accv g0, g1; g0[0] = bf2f(gv.x & 0xffffu); g0[1] = bf2f(gv.x >> 16); g0[2] = bf2f(gv.y & 0xffffu); g0[3] = bf2f(gv.y >> 16);
                    g1[0] = bf2f(gv.z & 0xffffu); g1[1] = bf2f(gv.z >> 16); g1[2] = bf2f(gv.w & 0xffffu); g1[3] = bf2f(gv.w >> 16);
                    *(v4u*)(mix + (size_t)(c * 256 + i) * DM + h * 256 + bj * 128 + e0) = pack8(acc[ai][bj][m][0] * rn * hn[bj][0] * g0, acc[ai][bj][m][1] * rn * hn[bj][1] * g1); } }
        asm volatile("s_waitcnt lgkmcnt(0)" ::: "memory"); __builtin_amdgcn_s_barrier(); asm volatile("" ::: "memory");
    }
};

struct SchedKV {
    int G, c;
    __device__ __forceinline__ bool next(int i, Unit& u) const { const int L = i * G + c; if (L >= NH * NCH * 2) return false; u.z = L & 1; u.pm = (L >> 1) & (NCH - 1); u.pn = L >> 7; return true; }
    __device__ __forceinline__ size_t a_off(const Unit& u) const { return ((size_t)(u.pn * NCH + u.pm) * 256 * KCAT) * 2; }
    __device__ __forceinline__ size_t b_off(const Unit& u) const { return ((size_t)u.z * RD * S_ + (size_t)u.pn * 256 * S_ + (size_t)u.pm * 256) * 2; }
};
struct SchedS {
    int G, c;
    __device__ __forceinline__ bool next(int i, Unit& u) const { const int L = i * G + c; if (L >= NH * NCH) return false; u.z = 0; u.pm = L & (NCH - 1); u.pn = L >> 6; return true; }
    __device__ __forceinline__ size_t a_off(const Unit& u) const { return ((size_t)u.pm * 256 * RD + (size_t)u.pn * 256) * 2; }
    __device__ __forceinline__ size_t b_off(const Unit& u) const { return a_off(u); }
};
struct SchedPool {
    int G, c;
    __device__ __forceinline__ bool next(int i, Unit& u) const { const int L = i * G + c; if (L >= NCH * 8) return false; u.z = 0; u.pn = L & 7; u.pm = L >> 3; return true; }
    __device__ __forceinline__ size_t a_off(const Unit& u) const { return ((size_t)u.pm * 256 * PD + (size_t)(u.pn >> 1) * 512) * 2; }
    __device__ __forceinline__ size_t b_off(const Unit& u) const { return ((size_t)u.pn * 256 * 512) * 2; }
};
struct SchedOut {
    int G, c;
    __device__ __forceinline__ bool next(int i, Unit& u) const { const int L = i * G + c; if (L >= NH * NCH) return false; u.z = 0; u.pm = L & (NCH - 1); u.pn = L >> 6; return true; }
    __device__ __forceinline__ size_t a_off(const Unit& u) const { return (((size_t)u.pn * S_ + (size_t)u.pm * 256) * KCAT) * 2; }
    __device__ __forceinline__ size_t b_off(const Unit& u) const { return ((size_t)(u.pn * NCH + u.pm) * 256 * KCAT) * 2; }
};

struct Frame {
    LAS unsigned char* lds;
    volatile LAS unsigned* MISC;
    int tid, lane, wave, G;
};

__device__ __forceinline__ float wave_sum(float v) {
#pragma unroll
    for (int o = 1; o < 64; o <<= 1) v += __shfl_xor(v, o);
    return v;
}

__device__ __forceinline__ void tr_matrix(Frame& F, const float* __restrict__ W, int K, int N, const float* __restrict__ gain, bf16* WT, int blk, int dblk, int doff, int gwi, int ngw) {
    LAS float* scr = (LAS float*)(F.lds + F.wave * TR_BYTES);
    const int nblk = N / 64, nitems = (K / 64) * nblk, lane = F.lane;
    const int lr = lane >> 4, lc = (lane & 15) * 4;
    int it = gwi; if (it >= nitems) return;
    f32x4 v[16]; float gs[16];
    int k0 = 64 * (it / nblk), n0 = 64 * (it % nblk);
#pragma unroll
    for (int i = 0; i < 16; ++i) { v[i] = *(const f32x4*)(W + (size_t)(k0 + lr + 4 * i) * N + n0 + lc); gs[i] = gain ? gain[k0 + lr + 4 * i] : 1.0f; }
    for (;;) {
#pragma unroll
        for (int i = 0; i < 16; ++i) { LAS float* d = scr + (lr + 4 * i) * TR_LD + lc; d[0] = v[i][0] * gs[i]; d[1] = v[i][1] * gs[i]; d[2] = v[i][2] * gs[i]; d[3] = v[i][3] * gs[i]; }
        const int ck0 = k0, cn0 = n0; const int itn = it + ngw; const bool more = itn < nitems;
        if (more) { k0 = 64 * (itn / nblk); n0 = 64 * (itn % nblk);
#pragma unroll
            for (int i = 0; i < 16; ++i) { v[i] = *(const f32x4*)(W + (size_t)(k0 + lr + 4 * i) * N + n0 + lc); gs[i] = gain ? gain[k0 + lr + 4 * i] : 1.0f; } }
        LDS_WAIT(); asm volatile("" ::: "memory");
        const int cc = lane & 7;
        const int drow0 = (cn0 / blk) * dblk + doff + (cn0 % blk);
#pragma unroll
        for (int j = 0; j < 8; ++j) { const int n = (lane >> 3) + 8 * j; const LAS float* sp = scr + (8 * cc) * TR_LD + n;
            float t[8];
#pragma unroll
            for (int q = 0; q < 8; ++q) t[q] = sp[q * TR_LD];
            v4u o; o.x = pk2t(t[0], t[1]); o.y = pk2t(t[2], t[3]); o.z = pk2t(t[4], t[5]); o.w = pk2t(t[6], t[7]);
            *(v4u*)(WT + (size_t)(drow0 + n) * K + ck0 + 8 * cc) = o; }
        LDS_WAIT(); asm volatile("" ::: "memory");
        if (!more) break;
        it = itn;
    }
}

template <int W> __device__ __forceinline__ void pooled_block(const bf16* __restrict__ pbuf, bf16* __restrict__ pooled, int s0, int cv) {
    constexpr int RB = 8, LO = W / 2, HI = W - 1 - LO, NR = RB + W - 1;
    v4u raw[NR];
#pragma unroll
    for (int q = 0; q < NR; ++q) { const int r = s0 - LO + q; const int rc = r < 0 ? 0 : (r >= S_ ? S_ - 1 : r); raw[q] = *(const v4u*)(pbuf + (size_t)rc * PD + cv * 8); }
#pragma unroll
    for (int q = 0; q < NR; ++q) { const int r = s0 - LO + q; if (r < 0 || r >= S_) raw[q] = (v4u){0u, 0u, 0u, 0u}; }
    accv ra = {0.f, 0.f, 0.f, 0.f}, rb = {0.f, 0.f, 0.f, 0.f};
#pragma unroll
    for (int q = 0; q < W; ++q) { accv a, b; unpack8(raw[q], a, b); ra += a; rb += b; }
#pragma unroll
    for (int i = 0; i < RB; ++i) { const int s = s0 + i; int st = s - LO; st = st < 0 ? 0 : st; int en = s + HI + 1; en = en > S_ ? S_ : en; const float inv = 1.0f / (float)(en - st);
        accv sa, sb; unpack8(raw[i + LO], sa, sb);
        *(v4u*)(pooled + (size_t)s * PD + cv * 8) = pack8(ra * inv - sa, rb * inv - sb);
        if (i < RB - 1) { accv a, b, c, d; unpack8(raw[i + W], a, b); unpack8(raw[i], c, d); ra += a - c; rb += b - d; } }
}
struct Args { const float* in[19]; const int* pos; float* out; unsigned char* ws; int ph_lo, ph_hi; };
static_assert(sizeof(Args) == 19 * 8 + 8 + 8 + 8 + 8, "Args has no padding");

enum { IN_X = 0, IN_POS = 1, IN_F1N = 2, IN_F1G = 3, IN_F1U = 4, IN_F1D = 5, IN_MIXN = 6, IN_WIN = 7, IN_DECF = 8, IN_DECB = 9, IN_HNORM = 10, IN_POOLW = 11, IN_PSCALE = 12,
       IN_WOUT = 13, IN_F2N = 14, IN_F2G = 15, IN_F2U = 16, IN_F2D = 17, IN_FINN = 18 };
constexpr int NPHASE = 11;
#ifndef MK_DUP
#define MK_DUP (-1)
#endif
#ifndef MK_SUB
#define MK_SUB 0
#endif
#define SUBON(k) (!rep || MK_SUB == 0 || MK_SUB == (k))
#ifndef MK_PHASE_MASK
#define MK_PHASE_MASK 0x7ff
#endif

typedef const __attribute__((address_space(4))) Args* KArgs;
__device__ __forceinline__ KArgs kargs() { KArgs p = (KArgs)__builtin_amdgcn_kernarg_segment_ptr(); asm volatile("" : "+s"(p)); return p; }
#define GP(T, p) ((T*)(GAS T*)(p))
__device__ __forceinline__ void grid_sync(Frame& F) {
    KArgs ap = kargs(); XcdBarrier b; b.bar = (unsigned*)(GP(unsigned char, ap->ws) + WS_CTL) + CW_BAR; b.x = xb_xcc_id(); b.st = F.MISC + 8; xcd_barrier(b);
}

__global__ void __launch_bounds__(NWAVES * 64, 2) fwd_kernel(Args args) {
    extern __shared__ __attribute__((aligned(16))) unsigned char lds[];
    Frame F;
    F.lds = (LAS unsigned char*)lds;
    F.MISC = (volatile LAS unsigned*)(F.lds + MISC_OFF);
    F.tid = threadIdx.x; F.lane = F.tid & 63; F.wave = __builtin_amdgcn_readfirstlane(F.tid >> 6);
    F.G = gridDim.x;
    if (F.tid < 64) F.MISC[F.tid] = 0u;
    __syncthreads();
    { KArgs ap = kargs(); (void)xcd_barrier_post((unsigned*)(GP(unsigned char, ap->ws) + WS_CTL) + CW_BAR, F.MISC + 8); }
    const int lo = args.ph_lo, hi = args.ph_hi;
#define IN(k) (lo <= (k) && (k) < hi)
#define PHON(k) (((MK_PHASE_MASK) >> (k)) & 1)
#define SEAM(k) do { if (IN(k) && IN((k) + 1)) grid_sync(F); } while (0)
#if MK_DUP == 0
#define RL0 for (int rep = 0; rep < 2; ++rep)
#else
#define RL0 if (const int rep = 0; true)
#endif
#if MK_DUP == 1
#define RL1 for (int rep = 0; rep < 2; ++rep)
#else
#define RL1 if (const int rep = 0; true)
#endif
#if MK_DUP == 2
#define RL2 for (int rep = 0; rep < 2; ++rep)
#else
#define RL2 if (const int rep = 0; true)
#endif
#if MK_DUP == 3
#define RL3 for (int rep = 0; rep < 2; ++rep)
#else
#define RL3 if (const int rep = 0; true)
#endif
#if MK_DUP == 4
#define RL4 for (int rep = 0; rep < 2; ++rep)
#else
#define RL4 if (const int rep = 0; true)
#endif
#if MK_DUP == 5
#define RL5 for (int rep = 0; rep < 2; ++rep)
#else
#define RL5 if (const int rep = 0; true)
#endif
#if MK_DUP == 6
#define RL6 for (int rep = 0; rep < 2; ++rep)
#else
#define RL6 if (const int rep = 0; true)
#endif
#if MK_DUP == 7
#define RL7 for (int rep = 0; rep < 2; ++rep)
#else
#define RL7 if (const int rep = 0; true)
#endif
#if MK_DUP == 8
#define RL8 for (int rep = 0; rep < 2; ++rep)
#else
#define RL8 if (const int rep = 0; true)
#endif
#if MK_DUP == 9
#define RL9 for (int rep = 0; rep < 2; ++rep)
#else
#define RL9 if (const int rep = 0; true)
#endif
#if MK_DUP == 10
#define RL10 for (int rep = 0; rep < 2; ++rep)
#else
#define RL10 if (const int rep = 0; true)
#endif
#define PHASE(k) if (PHON(k) && IN(k)) RL##k
#define PHASE_ENV KArgs ap = kargs(); unsigned char* ws = GP(unsigned char, ap->ws); float* rsq = (float*)(ws + WS_CTL) + CW_RSQ; float* xres = GP(float, ap->out); bf16* xb = (bf16*)(ws + WS_XB); \
    float* const dum_rs = (float*)(ws + WS_TAB + 65536); (void)rsq; (void)xres; (void)xb; (void)dum_rs; if (rep) grid_sync(F)
#define AIN(k) GP(const float, ap->in[k])
    const int gw = blockIdx.x * NWAVES + F.wave, NGW = F.G * NWAVES;
    const int gt = blockIdx.x * (NWAVES * 64) + F.tid, NGT = F.G * NWAVES * 64;

    PHASE(0) { PHASE_ENV;
        tr_matrix(F, AIN(IN_F1G), DM, FF, AIN(IN_F1N), (bf16*)(ws + WS_WGU1), 128, 256, 0, gw, NGW);
        tr_matrix(F, AIN(IN_F1U), DM, FF, AIN(IN_F1N), (bf16*)(ws + WS_WGU1), 128, 256, 128, gw, NGW);
        tr_matrix(F, AIN(IN_F1D), FF, DM, nullptr, (bf16*)(ws + WS_WD1), DM, 0, 0, gw, NGW);
        tr_matrix(F, AIN(IN_F2G), DM, FF, AIN(IN_F2N), (bf16*)(ws + WS_WGU2), 128, 256, 0, gw, NGW);
        tr_matrix(F, AIN(IN_F2U), DM, FF, AIN(IN_F2N), (bf16*)(ws + WS_WGU2), 128, 256, 128, gw, NGW);
        tr_matrix(F, AIN(IN_F2D), FF, DM, nullptr, (bf16*)(ws + WS_WD2), DM, 0, 0, gw, NGW);
#pragma unroll 1
        for (int g = 0; g < 4; ++g) tr_matrix(F, AIN(IN_POOLW) + (size_t)g * 512 * 512, 512, 512, nullptr, (bf16*)(ws + WS_WPOOL) + (size_t)g * 512 * 512, 512, 0, 0, gw, NGW);
        const float* x = AIN(IN_X);
        for (int m = gw; m < S_; m += NGW) {
            const f32x4* xr = (const f32x4*)(x + (size_t)m * DM) + F.lane; float ss = 0.f;
#pragma unroll
            for (int j = 0; j < 16; j += 2) { const f32x4 a = xr[64 * j], b = xr[64 * (j + 1)];
                ss += (a[0] * a[0] + a[1] * a[1]) + (a[2] * a[2] + a[3] * a[3]) + (b[0] * b[0] + b[1] * b[1]) + (b[2] * b[2] + b[3] * b[3]);
                v2u pa, pbv; pa.x = pk2(a[0], a[1]); pa.y = pk2(a[2], a[3]); pbv.x = pk2(b[0], b[1]); pbv.y = pk2(b[2], b[3]);
                *((v2u*)(xb + (size_t)m * DM) + F.lane + 64 * j) = pa; *((v2u*)(xb + (size_t)m * DM) + F.lane + 64 * (j + 1)) = pbv; }
            ss = wave_sum(ss);
            if (F.lane == 0) rsq[m] = ss;
        }
        if (gt < 16) ((float*)(ws + WS_TAB))[gt] = log2_sigmoid((gt < 8 ? AIN(IN_DECF) : AIN(IN_DECB))[gt & 7]);
        float* cst = (float*)(ws + WS_CS); const int* pos = GP(const int, ap->pos);
        for (int t = gt; t < S_ * 128; t += NGT) { const int s = t >> 7, i = t & 127;
            const float pw = (float)pow(10000.0, (double)((float)i * (1.0f / 128.0f))); const float fr = 1.0f / pw;
            const float ang = (float)pos[s] * fr;
            const double rev = (double)ang * 0.15915494309189533577; const float fr_rev = (float)(rev - rint(rev));
            cst[t] = __builtin_amdgcn_cosf(fr_rev); cst[(size_t)S_ * 128 + t] = __builtin_amdgcn_sinf(fr_rev); }
    }
    SEAM(0);

    PHASE(1) { PHASE_ENV;
        pg8::Gemm g{xb, (const bf16*)(ws + WS_WGU1), DM, DM, DM}; pg8::SchedGrid S; S.init(S_ / 256, 2 * FF / 256, F.G, (int)blockIdx.x, DM, DM);
        EpiGateUp E{rsq, (bf16*)(ws + WS_ACT)};
        pg8::gemm_phase(F.lds + RING_OFF, g, S, E);
        if (!rep) {
            const int nun = (S_ / 256) * (2 * FF / 256), rem = nun % F.G, first = rem, nidle = F.G - first;
            if ((int)blockIdx.x >= first) { const int gwi = ((int)blockIdx.x - first) * NWAVES + F.wave, ngw = nidle * NWAVES;
                tr_matrix(F, AIN(IN_WIN), DM, PROJ, AIN(IN_MIXN), (bf16*)(ws + WS_WIN), PROJ, 0, 0, gwi, ngw);
                tr_matrix(F, AIN(IN_WOUT), DM, DM, nullptr, (bf16*)(ws + WS_WOUT), DM, 0, 0, gwi, ngw); }
        }
    }
    SEAM(1);
    PHASE(2) { PHASE_ENV;
        pg8::Gemm g{(const bf16*)(ws + WS_ACT), (const bf16*)(ws + WS_WD1), FF, FF, FF}; pg8::SchedGrid S; S.init(S_ / 256, DM / 256, F.G, (int)blockIdx.x, FF, FF);
        EpiResid E{rep ? (bf16*)(ws + WS_ACAT) : xb, rep ? dum_rs : rsq + S_, 0.5f};
        pg8::gemm_phase(F.lds + RING_OFF, g, S, E);
    }
    SEAM(2);
    PHASE(3) { PHASE_ENV;
        pg8::Gemm g{xb, (const bf16*)(ws + WS_WIN), DM, DM, DM}; pg8::SchedGrid S; S.init(S_ / 256, PROJ / 256, F.G, (int)blockIdx.x, DM, DM);
        EpiZ E{rsq + S_, (const float*)(ws + WS_CS), (const float*)(ws + WS_TAB), (bf16*)(ws + WS_QROW), (bf16*)(ws + WS_KROW), (bf16*)(ws + WS_KDT), (bf16*)(ws + WS_GS), (bf16*)(ws + WS_PB),
               (bf16*)(ws + WS_ACAT), (bf16*)(ws + WS_BCAT)};
        pg8::gemm_phase(F.lds + RING_OFF, g, S, E);
    }
    SEAM(3);
    PHASE(4) { PHASE_ENV;
        if (SUBON(1)) {   const bf16* pbuf = (const bf16*)(ws + WS_PB); bf16* pooled = (bf16*)(ws + WS_POOLED);
            for (int t = gt; t < (S_ / 8) * (PD / 8); t += NGT) { const int s0 = (t >> 8) * 8, cv = t & 255, grp = cv >> 6;
                if (grp == 0) pooled_block<2>(pbuf, pooled, s0, cv); else if (grp == 1) pooled_block<4>(pbuf, pooled, s0, cv);
                else if (grp == 2) pooled_block<8>(pbuf, pooled, s0, cv); else pooled_block<16>(pbuf, pooled, s0, cv); }
            VM_WAIT(); __syncthreads();
        }
        if (SUBON(2)) {   pg8::Gemm g{(const bf16*)(ws + WS_BCAT), (const bf16*)(ws + WS_KDT), KCAT, S_, CH}; SchedKV S{F.G, (int)blockIdx.x};
            EpiKV E{(bf16*)(ws + WS_BCAT)};
            pg8::gemm_phase(F.lds + RING_OFF, g, S, E); }
        if (SUBON(3)) {   pg8::Gemm g{(const bf16*)(ws + WS_QROW), (const bf16*)(ws + WS_KROW), RD, RD, HD}; SchedS S{F.G, (int)blockIdx.x};
            EpiS E{(const float*)(ws + WS_TAB), (bf16*)(ws + WS_ACAT)};
            pg8::gemm_phase(F.lds + RING_OFF, g, S, E); }
    }
    SEAM(4);
    PHASE(5) { PHASE_ENV;
        if (!rep) {   bf16* bcat = (bf16*)(ws + WS_BCAT);
            for (int t = gt; t < 2 * NH * HD * (HD / 8); t += NGT) { const int dir = t >> 16, rem = t & 65535, h = rem >> 13, e = (rem >> 5) & 255, dv = rem & 31;
                const float l2 = ((const float*)(ws + WS_TAB))[dir * 8 + h]; const float dC = fast_exp2(l2 * (float)CH);
                bf16* p0 = bcat + ((size_t)(h * NCH) * 256 + e) * KCAT + 256 + 256 * dir + dv * 8; const size_t cstep = (size_t)256 * KCAT;
                float run[8];
#pragma unroll
                for (int j = 0; j < 8; ++j) run[j] = 0.f;
#pragma unroll 1
                for (int cb = 0; cb < NCH; cb += 8) { v4u kv[8];
#pragma unroll
                    for (int q = 0; q < 8; ++q) { const int c = dir ? (NCH - 1 - (cb + q)) : (cb + q); kv[q] = *(const v4u*)(p0 + (size_t)c * cstep); }
#pragma unroll
                    for (int q = 0; q < 8; ++q) { const int c = dir ? (NCH - 1 - (cb + q)) : (cb + q);
                        v4u o; o.x = pk2(run[0], run[1]); o.y = pk2(run[2], run[3]); o.z = pk2(run[4], run[5]); o.w = pk2(run[6], run[7]);
                        *(v4u*)(p0 + (size_t)c * cstep) = o;
                        run[0] = run[0] * dC + bf2f(kv[q].x & 0xffffu); run[1] = run[1] * dC + bf2f(kv[q].x >> 16); run[2] = run[2] * dC + bf2f(kv[q].y & 0xffffu); run[3] = run[3] * dC + bf2f(kv[q].y >> 16);
                        run[4] = run[4] * dC + bf2f(kv[q].z & 0xffffu); run[5] = run[5] * dC + bf2f(kv[q].z >> 16); run[6] = run[6] * dC + bf2f(kv[q].w & 0xffffu); run[7] = run[7] * dC + bf2f(kv[q].w >> 16); } } }
            VM_WAIT(); __syncthreads();
        }
        {   pg8::Gemm g{(const bf16*)(ws + WS_POOLED), (const bf16*)(ws + WS_WPOOL), PD, 512, 512}; SchedPool S{F.G, (int)blockIdx.x};
            EpiPool E{AIN(IN_PSCALE), (bf16*)(ws + WS_MIX)};
            pg8::gemm_phase(F.lds + RING_OFF, g, S, E); }
    }
    SEAM(5);
    PHASE(6) { PHASE_ENV;
        pg8::Gemm g{(const bf16*)(ws + WS_ACAT), (const bf16*)(ws + WS_BCAT), KCAT, KCAT, KCAT}; SchedOut S{F.G, (int)blockIdx.x};
        EpiOut E{AIN(IN_HNORM), (const bf16*)(ws + WS_GS), (bf16*)(ws + WS_MIX), (LAS float*)(F.lds + EPI_SCR_OFF)};
        pg8::gemm_phase(F.lds + RING_OFF, g, S, E);
    }
    SEAM(6);
    PHASE(7) { PHASE_ENV;
        pg8::Gemm g{(const bf16*)(ws + WS_MIX), (const bf16*)(ws + WS_WOUT), DM, DM, DM}; pg8::SchedGrid S; S.init(S_ / 256, DM / 256, F.G, (int)blockIdx.x, DM, DM);
        EpiResid E{rep ? (bf16*)(ws + WS_ACAT) : xb, rep ? dum_rs : rsq + 2 * S_, 1.0f};
        pg8::gemm_phase(F.lds + RING_OFF, g, S, E);
    }
    SEAM(7);
    PHASE(8) { PHASE_ENV;
        pg8::Gemm g{xb, (const bf16*)(ws + WS_WGU2), DM, DM, DM}; pg8::SchedGrid S; S.init(S_ / 256, 2 * FF / 256, F.G, (int)blockIdx.x, DM, DM);
        EpiGateUp E{rsq + 2 * S_, (bf16*)(ws + WS_ACT)};
        pg8::gemm_phase(F.lds + RING_OFF, g, S, E);
    }
    SEAM(8);
    PHASE(9) { PHASE_ENV;
        pg8::Gemm g{(const bf16*)(ws + WS_ACT), (const bf16*)(ws + WS_WD2), FF, FF, FF}; pg8::SchedGrid S; S.init(S_ / 256, DM / 256, F.G, (int)blockIdx.x, FF, FF);
        EpiResid E{rep ? (bf16*)(ws + WS_WGU1) : xb, rep ? dum_rs : rsq + 3 * S_, 0.5f};
        pg8::gemm_phase(F.lds + RING_OFF, g, S, E);
    }
    SEAM(9);
    PHASE(10) { PHASE_ENV;
        const float* fn = AIN(IN_FINN);
        const unsigned tmo = __hip_atomic_load((unsigned*)(ws + WS_CTL) + CW_BAR + XB_TMO, RLX_AGENT);
        for (int m = gw; m < S_; m += NGW) { float rs = 1.0f / sqrtf(rsq[3 * S_ + m] * (1.0f / DM) + EPS);
            if (tmo) rs = __builtin_nanf("");
            const v4u* xr = (const v4u*)(xb + (size_t)m * DM) + F.lane; f32x4* orow = (f32x4*)(xres + (size_t)m * DM);
#pragma unroll
            for (int j = 0; j < 8; ++j) { const v4u w = xr[64 * j]; accv a, b; unpack8(w, a, b);
                const f32x4 g0 = *((const f32x4*)fn + 2 * (F.lane + 64 * j)), g1 = *((const f32x4*)fn + 2 * (F.lane + 64 * j) + 1);
                orow[2 * (F.lane + 64 * j)] = a * rs * g0; orow[2 * (F.lane + 64 * j) + 1] = b * rs * g1; } }
    }
#undef IN
#undef SEAM
}

#ifndef MK_N_LAUNCHES
#define MK_N_LAUNCHES 1
#endif
extern "C" void kernel_launch(void* const* d_in, const int* in_sizes, int n_in, void* d_out, int out_size, void* d_ws, size_t ws_size, hipStream_t stream) {
    static int grid = 0;
    if (grid == 0) {
        if (n_in != 19 || in_sizes[0] != S_ * DM || out_size != S_ * DM || ws_size < WS_END2) { fprintf(stderr, "kernel_launch: unexpected shapes (n_in %d, in0 %d, out %d, ws %zu); nothing launched\n", n_in, n_in > 0 ? in_sizes[0] : -1, out_size, ws_size); grid = -1; return; }
        int dev = 0, cus = 0, per_cu = 0;
        if (hipGetDevice(&dev) != hipSuccess || hipDeviceGetAttribute(&cus, hipDeviceAttributeMultiprocessorCount, dev) != hipSuccess) { fprintf(stderr, "kernel_launch: device query failed\n"); grid = -1; return; }
        if (hipFuncSetAttribute((const void*)fwd_kernel, hipFuncAttributeMaxDynamicSharedMemorySize, LDS_BYTES) != hipSuccess) { fprintf(stderr, "kernel_launch: hipFuncSetAttribute failed\n"); grid = -1; return; }
        if (hipOccupancyMaxActiveBlocksPerMultiprocessor(&per_cu, (const void*)fwd_kernel, NWAVES * 64, LDS_BYTES) != hipSuccess || per_cu < 1) { fprintf(stderr, "kernel_launch: occupancy query reports %d workgroups per CU\n", per_cu); per_cu = 1; }
        (void)hipGetLastError();
        grid = cus;
    }
    if (grid < 0) return;
    if (hipMemsetAsync((char*)d_ws + WS_CTL, 0, CTL_ZERO_BYTES, stream) != hipSuccess) { fprintf(stderr, "kernel_launch: memset failed\n"); return; }
    Args a{};
    for (int i = 0; i < 19; ++i) a.in[i] = (const float*)d_in[i];
    a.pos = (const int*)d_in[IN_POS]; a.out = (float*)d_out; a.ws = (unsigned char*)d_ws;
#if MK_N_LAUNCHES == 1
    a.ph_lo = 0; a.ph_hi = NPHASE;
    hipLaunchKernelGGL(fwd_kernel, dim3(grid), dim3(NWAVES * 64), LDS_BYTES, stream, a);
#else
    for (int p = 0; p < NPHASE; ++p) { a.ph_lo = p; a.ph_hi = p + 1; hipLaunchKernelGGL(fwd_kernel, dim3(grid), dim3(NWAVES * 64), LDS_BYTES, stream, a); }
#endif
    const hipError_t le = hipPeekAtLastError();
    if (le != hipSuccess) fprintf(stderr, "kernel_launch: launch failed: %s\n", hipGetErrorName(le));
}
```

```cpp
#include <hip/hip_runtime.h>
#include <cstdio>
#include <cstdint>

namespace pg8 {
#define PG8_LAS __attribute__((address_space(3)))
typedef unsigned short bf16_t;
typedef short bf16x8 __attribute__((ext_vector_type(8)));
typedef float f32x4 __attribute__((ext_vector_type(4)));
typedef unsigned u32x4 __attribute__((ext_vector_type(4)));
constexpr int BM = 256, BK = 64, HALF = 128, HTB = HALF * BK * 2  , STAGE_BYTES = 8 * HTB, NXCD = 8, WGM = 8;

__host__ __device__ __forceinline__ int lds_byte(int r, int c) { const int st = (r >> 4) * 2 + (c >> 5), rr = r & 15, cc = c & 31, ob = rr * 64 + cc * 2; return st * 1024 + (ob ^ (((ob >> 9) & 1) << 5)); }
__host__ __device__ __forceinline__ void stage_rc(int b, int& R, int& C) { const int st = b / 1024, sb = b % 1024, swz = sb ^ (((sb >> 9) & 1) << 5); R = (st >> 1) * 16 + swz / 64; C = (st & 1) * 32 + (swz % 64) / 2; }
__host__ __device__ __forceinline__ int perm32(int rho) { const int n = rho >> 4, i = rho & 15; return 8 * (i >> 2) + 4 * n + (i & 3); }

struct Unit { int pm, pn, z; };
struct Gemm { const bf16_t* A; const bf16_t* Bt; int lda, ldb, K; };

struct SchedGrid {
    int nM, nN, nwg, G, c; size_t astep, bstep;
    __device__ __forceinline__ void init(int nM_, int nN_, int G_, int c_, int lda, int ldb) { nM = nM_; nN = nN_; nwg = nM * nN; G = G_; c = c_; astep = (size_t)BM * lda * 2; bstep = (size_t)BM * ldb * 2; }
    __device__ __forceinline__ bool next(int i, Unit& u) const {
        const long L = (long)i * G + c; if (L >= nwg) return false;
        int wgid = (int)L; { const int q = nwg / NXCD, r = nwg % NXCD, xcd = wgid % NXCD, off = wgid / NXCD; wgid = (xcd < r ? xcd * (q + 1) : r * (q + 1) + (xcd - r) * q) + off; }
        const int nig = WGM * nN, gid = wgid / nig, fm = gid * WGM, gsz = (nM - fm) < WGM ? (nM - fm) : WGM;
        u.pm = fm + ((wgid % nig) % gsz); u.pn = (wgid % nig) / gsz; u.z = 0; return true;
    }
    __device__ __forceinline__ size_t a_off(const Unit& u) const { return (size_t)u.pm * astep; }
    __device__ __forceinline__ size_t b_off(const Unit& u) const { return (size_t)u.pn * bstep; }
};

__device__ __forceinline__ unsigned cvt_pk_bf16(float lo, float hi) { unsigned r; asm volatile("v_cvt_pk_bf16_f32 %0, %1, %2" : "=v"(r) : "v"(lo), "v"(hi)); return r; }

template <class Epi, class Sched>
__device__ __forceinline__ void gemm_phase(PG8_LAS unsigned char* lds, const Gemm g, const Sched& S, const Epi& E) {
    const int tid = threadIdx.x, wid = __builtin_amdgcn_readfirstlane(tid >> 6), lane = tid & 63, wr = wid >> 2, wc = wid & 3, fr = lane & 15, fq = lane >> 4;
    int nt = g.K / BK; asm volatile("" : "+s"(nt));
    unsigned voffA[2], voffB[2];
#pragma unroll
    for (int i = 0; i < 2; ++i) { int R, C; stage_rc(tid * 16 + i * 8192, R, C); const int Rb = (R & ~31) + perm32(R & 31);
        voffA[i] = (unsigned)(R * g.lda + C) * 2u; voffB[i] = (unsigned)(Rb * g.ldb + C) * 2u; }
    const size_t kstep = (size_t)(BK * 2);
    const size_t hstepA = (size_t)HALF * g.lda * 2, hstepB = (size_t)HALF * g.ldb * 2;
    const unsigned ldsw = (unsigned)wid * 1024u;
    const int aoff = lds_byte(wr * 64 + fr, fq * 8), boff = lds_byte(wc * 32 + fr, fq * 8);
#define PG8_SA(b, h) (((b) * 2 + (h)) * HTB)
#define PG8_SB(b, h) ((4 + (b) * 2 + (h)) * HTB)
#define PG8_STAGE(bufoff, gbase, voff) do { _Pragma("unroll") for (int _i = 0; _i < 2; ++_i) \
        __builtin_amdgcn_global_load_lds((const unsigned*)((const char*)(gbase) + (voff)[_i]), (PG8_LAS unsigned*)(lds + (bufoff) + ldsw + _i * 8192), 16, 0, 0); } while (0)
#define PG8_LDA(dst, b, h) do { _Pragma("unroll") for (int m = 0; m < 4; ++m) _Pragma("unroll") for (int k = 0; k < 2; ++k) dst[m][k] = *(const PG8_LAS bf16x8*)(lds + PG8_SA(b, h) + aoff + m * 2048 + k * 1024); } while (0)
#define PG8_LDB(dst, b, h) do { _Pragma("unroll") for (int n = 0; n < 2; ++n) _Pragma("unroll") for (int k = 0; k < 2; ++k) dst[n][k] = *(const PG8_LAS bf16x8*)(lds + PG8_SB(b, h) + boff + n * 2048 + k * 1024); } while (0)
#define PG8_MMA(ai, bj, At, Bt) do { __builtin_amdgcn_s_setprio(1); _Pragma("unroll") for (int m = 0; m < 4; ++m) _Pragma("unroll") for (int n = 0; n < 2; ++n) _Pragma("unroll") for (int k = 0; k < 2; ++k) \
        acc[ai][bj][m][n] = __builtin_amdgcn_mfma_f32_16x16x32_bf16(Bt[n][k], At[m][k], acc[ai][bj][m][n], 0, 0, 0); __builtin_amdgcn_s_setprio(0); } while (0)
#define PG8_WAIT_V(n) asm volatile("s_waitcnt vmcnt(" #n ")" ::: "memory")
#define PG8_WAIT_L(n) asm volatile("s_waitcnt lgkmcnt(" #n ")" ::: "memory")
#define PG8_BAR __builtin_amdgcn_s_barrier()
#define PG8_SCHED __builtin_amdgcn_sched_barrier(0)
    Unit cur, nxt; int ui = 0;
    if (!S.next(0, cur)) return;
    f32x4 acc[2][2][4][2];
#pragma unroll
    for (int a = 0; a < 2; ++a)
#pragma unroll
        for (int b = 0; b < 2; ++b)
#pragma unroll
            for (int m = 0; m < 4; ++m)
#pragma unroll
                for (int n = 0; n < 2; ++n) acc[a][b][m][n] = (f32x4){0.f, 0.f, 0.f, 0.f};
    bf16x8 At[4][2], B0[2][2], B1[2][2];
    const char* cA = (const char*)g.A + S.a_off(cur); const char* cB = (const char*)g.Bt + S.b_off(cur);
    PG8_STAGE(PG8_SB(0, 0), cB, voffB); PG8_STAGE(PG8_SB(0, 1), cB + hstepB, voffB); PG8_STAGE(PG8_SA(0, 0), cA, voffA); PG8_STAGE(PG8_SA(0, 1), cA + hstepA, voffA);
    if (wr == 1) PG8_BAR;
    PG8_WAIT_V(2); PG8_BAR;
    PG8_STAGE(PG8_SB(1, 0), cB + kstep, voffB); PG8_STAGE(PG8_SA(1, 0), cA + kstep, voffA); PG8_STAGE(PG8_SB(1, 1), cB + hstepB + kstep, voffB);
    PG8_WAIT_V(6); PG8_BAR;
    for (;;) {
        const bool has_next = S.next(ui + 1, nxt);
        const char* nA = has_next ? (const char*)g.A + S.a_off(nxt) : cA; const char* nB = has_next ? (const char*)g.Bt + S.b_off(nxt) : cB;
        for (int t = 0; t < nt; t += 2) {
            const bool last = (t == nt - 2);
            const char* a1 = cA + (size_t)(t + 1) * kstep;
            const char* a2 = last ? nA : cA + (size_t)(t + 2) * kstep; const char* b2 = last ? nB : cB + (size_t)(t + 2) * kstep;
            const char* a3 = a2 + kstep; const char* b3 = b2 + kstep;
            PG8_LDB(B0, 0, 0); PG8_LDB(B1, 0, 1); PG8_SCHED; PG8_LDA(At, 0, 0); PG8_STAGE(PG8_SA(1, 1), a1 + hstepA, voffA);
            PG8_WAIT_V(8); PG8_WAIT_L(0); PG8_BAR; PG8_MMA(0, 0, At, B0); PG8_MMA(0, 1, At, B1); PG8_BAR; PG8_SCHED;
            PG8_LDA(At, 0, 1); PG8_STAGE(PG8_SB(0, 0), b2, voffB); PG8_STAGE(PG8_SB(0, 1), b2 + hstepB, voffB); PG8_STAGE(PG8_SA(0, 0), a2, voffA);
            PG8_WAIT_V(8); PG8_WAIT_L(0); PG8_BAR; PG8_MMA(1, 0, At, B0); PG8_MMA(1, 1, At, B1); PG8_BAR; PG8_SCHED;
            PG8_LDB(B0, 1, 0); PG8_LDB(B1, 1, 1); PG8_SCHED; PG8_LDA(At, 1, 0); PG8_STAGE(PG8_SA(0, 1), a2 + hstepA, voffA);
            PG8_WAIT_V(8); PG8_WAIT_L(0); PG8_BAR; PG8_MMA(0, 0, At, B0); PG8_MMA(0, 1, At, B1); PG8_BAR; PG8_SCHED;
            PG8_LDA(At, 1, 1); PG8_STAGE(PG8_SB(1, 0), b3, voffB); PG8_STAGE(PG8_SB(1, 1), b3 + hstepB, voffB); PG8_STAGE(PG8_SA(1, 0), a3, voffA);
            PG8_WAIT_V(8); PG8_WAIT_L(0); PG8_BAR; PG8_MMA(1, 0, At, B0); PG8_MMA(1, 1, At, B1); PG8_BAR; PG8_SCHED;
        }
        if (wr == 0) PG8_BAR;
        { int fr2 = fr, fq2 = fq; asm volatile("" : "+v"(fr2), "+v"(fq2));
          E(acc, cur, wr, wc, fr2, fq2); }
        if (!has_next) break;
#pragma unroll
        for (int a = 0; a < 2; ++a)
#pragma unroll
            for (int b = 0; b < 2; ++b)
#pragma unroll
                for (int m = 0; m < 4; ++m)
#pragma unroll
                    for (int n = 0; n < 2; ++n) acc[a][b][m][n] = (f32x4){0.f, 0.f, 0.f, 0.f};
        cur = nxt; cA = nA; cB = nB; ++ui;
        if (wr == 1) PG8_BAR;
    }
    PG8_WAIT_V(0);
    PG8_BAR;
#undef PG8_SA
#undef PG8_SB
#undef PG8_STAGE
#undef PG8_LDA
#undef PG8_LDB
#undef PG8_MMA
#undef PG8_WAIT_V
#undef PG8_WAIT_L
#undef PG8_BAR
#undef PG8_SCHED
}
}

constexpr int NWAVES = 8;
constexpr int S_ = 16384, DM = 4096, FF = 11008, PROJ = 10240, RD = 2048, NH = 8, HD = 256, CH = 256, NCH = S_ / CH, PD = 2048;
constexpr float EPS = 1e-6f;
constexpr int KCAT = 768;

constexpr size_t MiB = 1u << 20;
constexpr size_t WS_CTL = 0, CTL_ZERO_BYTES = 1 * MiB;
constexpr size_t WS_TAB = 1 * MiB;
constexpr size_t WS_CS = 2 * MiB;
constexpr size_t WS_WPOOL = 18 * MiB;
constexpr size_t WS_WIN = 20 * MiB, WS_WOUT = 100 * MiB, WS_WGU2 = 132 * MiB, WS_WD2 = 304 * MiB;
constexpr size_t WS_XB = 390 * MiB;
constexpr size_t WS_WGU1 = 518 * MiB, WS_WD1 = 690 * MiB, WS_ACT = 776 * MiB;
constexpr size_t WS_QROW = 518 * MiB, WS_KROW = 582 * MiB, WS_KDT = 646 * MiB  , WS_GS = 774 * MiB, WS_PB = 838 * MiB, WS_POOLED = 902 * MiB;
constexpr size_t WS_ACAT = 966 * MiB, WS_BCAT = 1158 * MiB, WS_END = 1350 * MiB;
constexpr size_t WS_MIX = 1350 * MiB, WS_END2 = 1478 * MiB;
static_assert(WS_WIN + (size_t)PROJ * DM * 2 <= WS_WOUT && WS_WOUT + (size_t)DM * DM * 2 <= WS_WGU2 && WS_WGU2 + (size_t)2 * FF * DM * 2 <= WS_WD2 && WS_WD2 + (size_t)DM * FF * 2 <= WS_XB, "weights map");
static_assert(WS_XB + (size_t)S_ * DM * 2 <= WS_WGU1 && WS_WGU1 + (size_t)2 * FF * DM * 2 <= WS_WD1 && WS_WD1 + (size_t)DM * FF * 2 <= WS_ACT && WS_ACT + (size_t)S_ * FF * 2 <= WS_END, "ffn map");
static_assert(WS_ACAT + (size_t)NH * S_ * KCAT * 2 <= WS_BCAT && WS_BCAT + (size_t)NH * NCH * HD * KCAT * 2 <= WS_END && WS_POOLED + (size_t)S_ * PD * 2 <= WS_ACAT, "mixer map");
constexpr int CW_BAR = 4096;
constexpr int CW_RSQ = 16384;

constexpr int RING_OFF = 0, RING_BYTES = 131072;
constexpr int LDS_BYTES = 147456;
constexpr int EPI_SCR_OFF = 135168;
constexpr int MISC_OFF = LDS_BYTES - 256;
constexpr int TR_LD = 65, TR_BYTES = 64 * TR_LD * 4;
static_assert(NWAVES * TR_BYTES <= EPI_SCR_OFF + 4096 && EPI_SCR_OFF + 4096 <= MISC_OFF, "LDS map");

#define GAS __attribute__((address_space(1)))
#define LAS __attribute__((address_space(3)))
typedef unsigned short bf16;
typedef unsigned v4u __attribute__((ext_vector_type(4)));
typedef unsigned v2u __attribute__((ext_vector_type(2)));
typedef float f32x4 __attribute__((ext_vector_type(4)));
typedef GAS unsigned gu32;
#define RLX_AGENT __ATOMIC_RELAXED, __HIP_MEMORY_SCOPE_AGENT
#define LDS_WAIT() asm volatile("s_waitcnt lgkmcnt(0)" ::: "memory")
#define VM_WAIT() asm volatile("s_waitcnt vmcnt(0)" ::: "memory")
__device__ __forceinline__ unsigned f2bf(float f) { unsigned u = __builtin_bit_cast(unsigned, f); return (u + 0x7fffu + ((u >> 16) & 1u)) >> 16; }
typedef __bf16 bf16x2_t __attribute__((ext_vector_type(2)));
typedef float f32x2_t __attribute__((ext_vector_type(2)));
__device__ __forceinline__ unsigned pk2t(float lo, float hi) { const f32x2_t v = {lo, hi}; return __builtin_bit_cast(unsigned, __builtin_convertvector(v, bf16x2_t)); }
__device__ __forceinline__ unsigned pk2(float lo, float hi) { return pg8::cvt_pk_bf16(lo, hi); }
__device__ __forceinline__ float bf2f(unsigned h) { return __builtin_bit_cast(float, h << 16); }
__device__ __forceinline__ float fast_exp2(float x) { return __builtin_amdgcn_exp2f(x); }
__device__ __forceinline__ float silu_f(float x) { return x * __builtin_amdgcn_rcpf(1.0f + fast_exp2(-1.4426950408889634f * x)); }
__device__ __forceinline__ float log2_sigmoid(float x) { return -log1pf(expf(-x)) * 1.4426950408889634f; }

#define XB_TMO      128
#define XB_XCNT(j)  (256  + 64 * (j))
#define XB_XSUB(j)  (1280 + 64 * (j))
#define XB_XGEN(j)  (2304 + 64 * (j))
#define XB_TOP      3328
#define XB_TOPGEN   3392
#define XCD_BAR_WORDS 3456
#define XB_SPIN_CAP (1u << 18)

__device__ __forceinline__ unsigned xb_ld(unsigned* p)              { return __hip_atomic_load(p, __ATOMIC_RELAXED, __HIP_MEMORY_SCOPE_AGENT); }
__device__ __forceinline__ unsigned xb_add(unsigned* p, unsigned v) { return __hip_atomic_fetch_add(p, v, __ATOMIC_RELAXED, __HIP_MEMORY_SCOPE_AGENT); }
__device__ __forceinline__ unsigned xb_xcc_id() { return (unsigned)__builtin_amdgcn_s_getreg((3 << 11) | 20) & 0xFu; }
#define XB_SPIN(cond, bar) do { unsigned _sp = 0; while (cond) { __builtin_amdgcn_s_sleep(1); \
    if ((++_sp & 255u) == 0u) { if (xb_ld(&(bar)[XB_TMO])) break; if (_sp > XB_SPIN_CAP) { atomicAdd(&(bar)[XB_TMO], 1u); break; } } } } while (0)

struct XcdBarrier {
    unsigned* bar; unsigned x;
    volatile LAS unsigned* st;
};
__device__ __forceinline__ XcdBarrier xcd_barrier_post(unsigned* bar, volatile LAS unsigned* st) {
    XcdBarrier b; b.bar = bar; b.x = xb_xcc_id(); b.st = st;
    if (threadIdx.x == 0) (void)xb_add(&bar[XB_XCNT(b.x)], 1u);
    return b;
}
__device__ __forceinline__ void xcd_barrier_complete(unsigned* bar, unsigned x, unsigned& nloc, unsigned& nx) {
    const unsigned G = gridDim.x * gridDim.y * gridDim.z;
    unsigned sum, cnt, mine, sp = 0u;
    for (;;) {
        sum = 0u; cnt = 0u; mine = 0u;
#pragma unroll
        for (unsigned j = 0; j < 16; ++j) { const unsigned c = xb_ld(&bar[XB_XCNT(j)]); sum += c; cnt += (c > 0u) ? 1u : 0u; mine = (j == x) ? c : mine; }
        if (sum == G) break;
        __builtin_amdgcn_s_sleep(1);
        if ((++sp & 255u) == 0u) { if (xb_ld(&bar[XB_TMO])) break; if (sp > XB_SPIN_CAP) { atomicAdd(&bar[XB_TMO], 1u); break; } }
    }
    nloc = mine > 0u ? mine : 1u; nx = cnt > 0u ? cnt : 1u;
}
__device__ __forceinline__ void xcd_barrier(const XcdBarrier& b) {
    asm volatile("s_waitcnt vmcnt(0)" ::: "memory");
    __syncthreads();
    if (threadIdx.x == 0) {
        unsigned* bar = b.bar;
        __builtin_amdgcn_s_waitcnt(0);
        unsigned nloc = b.st[0], nx = b.st[1];
        if (nloc == 0u) { xcd_barrier_complete(bar, b.x, nloc, nx); b.st[0] = nloc; b.st[1] = nx; }
        const unsigned old = xb_add(&bar[XB_XSUB(b.x)], 1u);
        const unsigned gen = old / nloc;
        if (old + 1u == (gen + 1u) * nloc) {
            __builtin_amdgcn_fence(__ATOMIC_RELEASE, "agent");
            asm volatile("s_waitcnt vmcnt(0)" ::: "memory");
            const unsigned og = xb_add(&bar[XB_TOP], 1u);
            const unsigned tg = og / nx;
            if (og + 1u == (tg + 1u) * nx) xb_add(&bar[XB_TOPGEN], 1u);
            else XB_SPIN(xb_ld(&bar[XB_TOPGEN]) == tg, bar);
            __builtin_amdgcn_fence(__ATOMIC_ACQUIRE, "agent");
            xb_add(&bar[XB_XGEN(b.x)], 1u);
            asm volatile("s_waitcnt vmcnt(0)" ::: "memory");
        } else {
            XB_SPIN(xb_ld(&bar[XB_XGEN(b.x)]) == gen, bar);
            __builtin_amdgcn_fence(__ATOMIC_ACQUIRE, "agent");
            asm volatile("s_waitcnt vmcnt(0)" ::: "memory");
        }
    }
    __syncthreads();
}

using pg8::Unit;
typedef pg8::f32x4 accv;

__device__ __forceinline__ v4u pack8(const accv& v0, const accv& v1) { v4u w; w.x = pk2(v0[0], v0[1]); w.y = pk2(v0[2], v0[3]); w.z = pk2(v1[0], v1[1]); w.w = pk2(v1[2], v1[3]); return w; }

struct EpiGateUp {
    static constexpr bool PERM = true;
    const float* rowsq; bf16* act;
    __device__ __forceinline__ void operator()(const accv (&acc)[2][2][4][2], const Unit& u, int wr, int wc, int fr, int fq) const {
        const int row0 = u.pm * 256 + wr * 64 + fr, col0 = u.pn * 128 + wc * 32 + 8 * fq;
#pragma unroll
        for (int ai = 0; ai < 2; ++ai)
#pragma unroll
            for (int m = 0; m < 4; ++m) { const int row = row0 + ai * 128 + m * 16; const float rs = 1.0f / sqrtf(rowsq[row] * (1.0f / DM) + EPS);
                accv o[2];
#pragma unroll
                for (int n = 0; n < 2; ++n)
#pragma unroll
                    for (int j = 0; j < 4; ++j) { const float g = acc[ai][0][m][n][j] * rs, up = acc[ai][1][m][n][j] * rs; o[n][j] = silu_f(g) * up; }
                *(v4u*)(act + (size_t)row * FF + col0) = pack8(o[0], o[1]); }
    }
};

__device__ __forceinline__ void unpack8(const v4u& w, accv& a, accv& b) { a[0] = bf2f(w.x & 0xffffu); a[1] = bf2f(w.x >> 16); a[2] = bf2f(w.y & 0xffffu); a[3] = bf2f(w.y >> 16);
    b[0] = bf2f(w.z & 0xffffu); b[1] = bf2f(w.z >> 16); b[2] = bf2f(w.w & 0xffffu); b[3] = bf2f(w.w >> 16); }
struct EpiResid {
    static constexpr bool PERM = true;
    bf16* xs; float* rowsq; float scale;
    __device__ __forceinline__ void operator()(const accv (&acc)[2][2][4][2], const Unit& u, int wr, int wc, int fr, int fq) const {
        const int row0 = u.pm * 256 + wr * 64 + fr, col0 = u.pn * 256 + wc * 32 + 8 * fq;
        v4u xo[2][4][2];
#pragma unroll
        for (int ai = 0; ai < 2; ++ai)
#pragma unroll
            for (int m = 0; m < 4; ++m)
#pragma unroll
                for (int bj = 0; bj < 2; ++bj) xo[ai][m][bj] = *(const v4u*)(xs + (size_t)(row0 + ai * 128 + m * 16) * DM + col0 + bj * 128);
        asm volatile("" ::: "memory");
#pragma unroll
        for (int ai = 0; ai < 2; ++ai)
#pragma unroll
            for (int m = 0; m < 4; ++m) { const int row = row0 + ai * 128 + m * 16; const size_t off = (size_t)row * DM + col0; float ss = 0.f;
#pragma unroll
                for (int bj = 0; bj < 2; ++bj) { accv v0, v1; unpack8(xo[ai][m][bj], v0, v1);
                    v0 = v0 + acc[ai][bj][m][0] * scale; v1 = v1 + acc[ai][bj][m][1] * scale;
                    ss += (v0[0] * v0[0] + v0[1] * v0[1]) + (v0[2] * v0[2] + v0[3] * v0[3]) + (v1[0] * v1[0] + v1[1] * v1[1]) + (v1[2] * v1[2] + v1[3] * v1[3]);
                    *(v4u*)(xs + off + bj * 128) = pack8(v0, v1); }
                ss += __shfl_xor(ss, 16); ss += __shfl_xor(ss, 32);
                if (fq == 0) atomicAdd(rowsq + row, ss); }
    }
};

struct EpiZ {
    static constexpr bool PERM = true;
    const float* rowsq; const float* cs; const float* l2tab;
    bf16 *qrow, *krow, *kdt, *gs, *pb, *acat, *bcat;
    __device__ __forceinline__ void operator()(const accv (&acc)[2][2][4][2], const Unit& u, int wr, int wc, int fr, int fq) const {
        const int type = u.pn >> 3, h = u.pn & 7, c = u.pm;
        const int i0 = wr * 64 + fr, d1 = wc * 32 + 8 * fq;
        if (type <= 1) {
            const float l2a = l2tab[h], l2b = l2tab[8 + h];
#pragma unroll
            for (int ai = 0; ai < 2; ++ai)
#pragma unroll
                for (int m = 0; m < 4; ++m) { const int i = i0 + ai * 128 + m * 16, s = c * 256 + i;
                    const float rs = 1.0f / sqrtf(rowsq[s] * (1.0f / DM) + EPS);
                    const accv c0 = *(const accv*)(cs + (size_t)s * 128 + d1), c1 = *(const accv*)(cs + (size_t)s * 128 + d1 + 4);
                    const accv s0 = *(const accv*)(cs + (size_t)S_ * 128 + (size_t)s * 128 + d1), s1 = *(const accv*)(cs + (size_t)S_ * 128 + (size_t)s * 128 + d1 + 4);
                    accv r1[2], r2[2];
                    r1[0] = acc[ai][0][m][0] * c0 - acc[ai][1][m][0] * s0; r1[1] = acc[ai][0][m][1] * c1 - acc[ai][1][m][1] * s1;
                    r2[0] = acc[ai][0][m][0] * s0 + acc[ai][1][m][0] * c0; r2[1] = acc[ai][0][m][1] * s1 + acc[ai][1][m][1] * c1;
                    if (type == 0) {
                        const size_t o = (size_t)s * RD + h * 256 + d1;
                        *(v4u*)(qrow + o) = pack8(r1[0] * rs, r1[1] * rs); *(v4u*)(qrow + o + 128) = pack8(r2[0] * rs, r2[1] * rs);
                        const float sf = rs * fast_exp2(l2a * (float)(i + 1)), sb = rs * fast_exp2(l2b * (float)(CH - i));
                        const size_t oa = ((size_t)h * S_ + s) * KCAT + 256 + d1;
                        *(v4u*)(acat + oa) = pack8(r1[0] * sf, r1[1] * sf); *(v4u*)(acat + oa + 128) = pack8(r2[0] * sf, r2[1] * sf);
                        *(v4u*)(acat + oa + 256) = pack8(r1[0] * sb, r1[1] * sb); *(v4u*)(acat + oa + 384) = pack8(r2[0] * sb, r2[1] * sb);
                    } else {
                        const float rk = rs * 0.0625f;
                        const size_t o = (size_t)s * RD + h * 256 + d1;
                        *(v4u*)(krow + o) = pack8(r1[0] * rk, r1[1] * rk); *(v4u*)(krow + o + 128) = pack8(r2[0] * rk, r2[1] * rk);
                        const float sf = rk * fast_exp2(l2a * (float)(CH - 1 - i)), sb = rk * fast_exp2(l2b * (float)i);
                        bf16* tf = kdt + ((size_t)h * 256 + d1) * S_ + s; bf16* tb = tf + (size_t)RD * S_;
#pragma unroll
                        for (int n = 0; n < 2; ++n)
#pragma unroll
                            for (int j = 0; j < 4; ++j) { const size_t t = (size_t)(4 * n + j) * S_;
                                tf[t] = (bf16)f2bf(r1[n][j] * sf); tf[t + (size_t)128 * S_] = (bf16)f2bf(r2[n][j] * sf);
                                tb[t] = (bf16)f2bf(r1[n][j] * sb); tb[t + (size_t)128 * S_] = (bf16)f2bf(r2[n][j] * sb); }
                    }
                    asm volatile("" ::: "memory"); }
        } else if (type == 2) {
            bf16* base = bcat + ((size_t)(h * NCH + c) * 256) * KCAT;
#pragma unroll
            for (int ai = 0; ai < 2; ++ai)
#pragma unroll
                for (int m = 0; m < 4; ++m) { const int i = i0 + ai * 128 + m * 16, s = c * 256 + i;
                    const float rs = 1.0f / sqrtf(rowsq[s] * (1.0f / DM) + EPS);
#pragma unroll
                    for (int bj = 0; bj < 2; ++bj)
#pragma unroll
                        for (int n = 0; n < 2; ++n)
#pragma unroll
                            for (int j = 0; j < 4; ++j) base[(size_t)(bj * 128 + d1 + 4 * n + j) * KCAT + i] = (bf16)f2bf(acc[ai][bj][m][n][j] * rs); }
        } else {
            bf16* dst = (type == 3) ? gs : pb;
#pragma unroll
            for (int ai = 0; ai < 2; ++ai)
#pragma unroll
                for (int m = 0; m < 4; ++m) { const int i = i0 + ai * 128 + m * 16, s = c * 256 + i;
                    const float rs = 1.0f / sqrtf(rowsq[s] * (1.0f / DM) + EPS);
#pragma unroll
                    for (int bj = 0; bj < 2; ++bj) { accv v0 = acc[ai][bj][m][0] * rs, v1 = acc[ai][bj][m][1] * rs;
                        if (type == 3) {
#pragma unroll
                            for (int j = 0; j < 4; ++j) { v0[j] = silu_f(v0[j]); v1[j] = silu_f(v1[j]); } }
                        *(v4u*)(dst + (size_t)s * RD + h * 256 + bj * 128 + d1) = pack8(v0, v1); } }
        }
    }
};

struct EpiKV {
    static constexpr bool PERM = true;
    bf16* bcat;
    __device__ __forceinline__ void operator()(const accv (&acc)[2][2][4][2], const Unit& u, int wr, int wc, int fr, int fq) const {
        bf16* base = bcat + ((size_t)(u.pn * NCH + u.pm) * 256) * KCAT + 256 + 256 * u.z + wc * 32 + 8 * fq;
        const int r0 = wr * 64 + fr;
#pragma unroll
        for (int ai = 0; ai < 2; ++ai)
#pragma unroll
            for (int m = 0; m < 4; ++m) { bf16* rp = base + (size_t)(r0 + ai * 128 + m * 16) * KCAT;
#pragma unroll
                for (int bj = 0; bj < 2; ++bj) *(v4u*)(rp + bj * 128) = pack8(acc[ai][bj][m][0], acc[ai][bj][m][1]); }
    }
};

struct EpiS {
    static constexpr bool PERM = true;
    const float* l2tab; bf16* acat;
    __device__ __forceinline__ void operator()(const accv (&acc)[2][2][4][2], const Unit& u, int wr, int wc, int fr, int fq) const {
        const int h = u.pn, c = u.pm;
        float l2a = l2tab[h], l2b = l2tab[8 + h];
        const int i0 = wr * 64 + fr, j0 = wc * 32 + 8 * fq;
        bf16* base = acat + ((size_t)h * S_ + (size_t)c * 256) * KCAT + j0;
#pragma unroll
        for (int ai = 0; ai < 2; ++ai)
#pragma unroll
            for (int m = 0; m < 4; ++m) { const int i = i0 + ai * 128 + m * 16;
#pragma unroll
                for (int bj = 0; bj < 2; ++bj) { accv v[2];
#pragma unroll
                    for (int n = 0; n < 2; ++n)
#pragma unroll
                        for (int j = 0; j < 4; ++j) { const float dd = (float)(i - (bj * 128 + j0 + 4 * n + j)); const float e = l2a * fmaxf(dd, 0.f) - l2b * fminf(dd, 0.f); v[n][j] = acc[ai][bj][m][n][j] * fast_exp2(e); }
                    *(v4u*)(base + (size_t)i * KCAT + bj * 128) = pack8(v[0], v[1]); }
                asm volatile("" : "+v"(l2a), "+v"(l2b) :: "memory"); }
    }
};

struct EpiPool {
    static constexpr bool PERM = true;
    const float* pscale; bf16* mix;
    __device__ __forceinline__ void operator()(const accv (&acc)[2][2][4][2], const Unit& u, int wr, int wc, int fr, int fq) const {
        const int row0 = u.pm * 256 + wr * 64 + fr, colp = u.pn * 256 + wc * 32 + 8 * fq;
        accv sc[2][2];
#pragma unroll
        for (int bj = 0; bj < 2; ++bj)
#pragma unroll
            for (int n = 0; n < 2; ++n) sc[bj][n] = *(const accv*)(pscale + colp + bj * 128 + 4 * n);
#pragma unroll
        for (int ai = 0; ai < 2; ++ai)
#pragma unroll
            for (int m = 0; m < 4; ++m) { bf16* rp = mix + (size_t)(row0 + ai * 128 + m * 16) * DM + RD + colp;
#pragma unroll
                for (int bj = 0; bj < 2; ++bj) *(v4u*)(rp + bj * 128) = pack8(acc[ai][bj][m][0] * sc[bj][0], acc[ai][bj][m][1] * sc[bj][1]); }
    }
};

struct EpiOut {
    static constexpr bool PERM = true;
    const float* hnorm; const bf16* gs; bf16* mix; LAS float* scr;
    __device__ __forceinline__ void operator()(const accv (&acc)[2][2][4][2], const Unit& u, int wr, int wc, int fr, int fq) const {
        const int h = u.pn, c = u.pm; const int i0 = wr * 64 + fr, e0 = wc * 32 + 8 * fq;
#pragma unroll
        for (int ai = 0; ai < 2; ++ai)
#pragma unroll
            for (int m = 0; m < 4; ++m) { float ss = 0.f;
#pragma unroll
                for (int bj = 0; bj < 2; ++bj)
#pragma unroll
                    for (int n = 0; n < 2; ++n) { const accv x = acc[ai][bj][m][n]; ss += (x[0] * x[0] + x[1] * x[1]) + (x[2] * x[2] + x[3] * x[3]); }
                ss += __shfl_xor(ss, 16); ss += __shfl_xor(ss, 32);
                if (fq == 0) scr[(i0 + ai * 128 + m * 16) * 4 + wc] = ss; }
        asm volatile("s_waitcnt lgkmcnt(0)" ::: "memory"); __builtin_amdgcn_s_barrier(); asm volatile("" ::: "memory");
        accv hn[2][2];
#pragma unroll
        for (int bj = 0; bj < 2; ++bj)
#pragma unroll
            for (int n = 0; n < 2; ++n) hn[bj][n] = *(const accv*)(hnorm + h * 256 + bj * 128 + e0 + 4 * n);
#pragma unroll
        for (int ai = 0; ai < 2; ++ai)
#pragma unroll
            for (int m = 0; m < 4; ++m) { const int i = i0 + ai * 128 + m * 16; const accv p = *(const LAS accv*)(scr + i * 4);
                const float rn = 1.0f / sqrtf(((p[0] + p[1]) + (p[2] + p[3])) * (1.0f / HD) + EPS);
                const size_t o = (size_t)(c * 256 + i) * RD + h * 256 + e0;
#pragma unroll
                for (int bj = 0; bj < 2; ++bj) { const v4u gv = *(const v4u*)(gs + o + bj * 128);
                    accv g0, g1; g0[0] = bf2f(gv.x & 0xffffu); g0[1] = bf2f(gv.x >> 16); g0[2] = bf2f(gv.y & 0xffffu); g0[3] = bf2f(gv.y >> 16);
                    g1[0] = bf2f(gv.z & 0xffffu); g1[1] = bf2f(gv.z >> 16); g1[2] = bf2f(gv.w & 0xffffu); g1[3] = bf2f(gv.w >> 16);
                    *(v4u*)(mix + (size_t)(c * 256 + i) * DM + h * 256 + bj * 128 + e0) = pack8(acc[ai][bj][m][0] * rn * hn[bj][0] * g0, acc[ai][bj][m][1] * rn * hn[bj][1] * g1); } }
        asm volatile("s_waitcnt lgkmcnt(0)" ::: "memory"); __builtin_amdgcn_s_barrier(); asm volatile("" ::: "memory");
    }
};

struct SchedKV {
    int G, c;
    __device__ __forceinline__ bool next(int i, Unit& u) const { const int L = i * G + c; if (L >= NH * NCH * 2) return false; u.z = L & 1; u.pm = (L >> 1) & (NCH - 1); u.pn = L >> 7; return true; }
    __device__ __forceinline__ size_t a_off(const Unit& u) const { return ((size_t)(u.pn * NCH + u.pm) * 256 * KCAT) * 2; }
    __device__ __forceinline__ size_t b_off(const Unit& u) const { return ((size_t)u.z * RD * S_ + (size_t)u.pn * 256 * S_ + (size_t)u.pm * 256) * 2; }
};
struct SchedS {
    int G, c;
    __device__ __forceinline__ bool next(int i, Unit& u) const { const int L = i * G + c; if (L >= NH * NCH) return false; u.z = 0; u.pm = L & (NCH - 1); u.pn = L >> 6; return true; }
    __device__ __forceinline__ size_t a_off(const Unit& u) const { return ((size_t)u.pm * 256 * RD + (size_t)u.pn * 256) * 2; }
    __device__ __forceinline__ size_t b_off(const Unit& u) const { return a_off(u); }
};
struct SchedPool {
    int G, c;
    __device__ __forceinline__ bool next(int i, Unit& u) const { const int L = i * G + c; if (L >= NCH * 8) return false; u.z = 0; u.pn = L & 7; u.pm = L >> 3; return true; }
    __device__ __forceinline__ size_t a_off(const Unit& u) const { return ((size_t)u.pm * 256 * PD + (size_t)(u.pn >> 1) * 512) * 2; }
    __device__ __forceinline__ size_t b_off(const Unit& u) const { return ((size_t)u.pn * 256 * 512) * 2; }
};
struct SchedOut {
    int G, c;
    __device__ __forceinline__ bool next(int i, Unit& u) const { const int L = i * G + c; if (L >= NH * NCH) return false; u.z = 0; u.pm = L & (NCH - 1); u.pn = L >> 6; return true; }
    __device__ __forceinline__ size_t a_off(const Unit& u) const { return (((size_t)u.pn * S_ + (size_t)u.pm * 256) * KCAT) * 2; }
    __device__ __forceinline__ size_t b_off(const Unit& u) const { return ((size_t)(u.pn * NCH + u.pm) * 256 * KCAT) * 2; }
};

struct Frame {
    LAS unsigned char* lds;
    volatile LAS unsigned* MISC;
    int tid, lane, wave, G;
};

__device__ __forceinline__ float wave_sum(float v) {
#pragma unroll
    for (int o = 1; o < 64; o <<= 1) v += __shfl_xor(v, o);
    return v;
}

__device__ __forceinline__ void tr_matrix(Frame& F, const float* __restrict__ W, int K, int N, const float* __restrict__ gain, bf16* WT, int blk, int dblk, int doff, int gwi, int ngw) {
    LAS float* scr = (LAS float*)(F.lds + F.wave * TR_BYTES);
    const int nblk = N / 64, nitems = (K / 64) * nblk, lane = F.lane;
    const int lr = lane >> 4, lc = (lane & 15) * 4;
    int it = gwi; if (it >= nitems) return;
    f32x4 v[16]; float gs[16];
    int k0 = 64 * (it / nblk), n0 = 64 * (it % nblk);
#pragma unroll
    for (int i = 0; i < 16; ++i) { v[i] = *(const f32x4*)(W + (size_t)(k0 + lr + 4 * i) * N + n0 + lc); gs[i] = gain ? gain[k0 + lr + 4 * i] : 1.0f; }
    for (;;) {
#pragma unroll
        for (int i = 0; i < 16; ++i) { LAS float* d = scr + (lr + 4 * i) * TR_LD + lc; d[0] = v[i][0] * gs[i]; d[1] = v[i][1] * gs[i]; d[2] = v[i][2] * gs[i]; d[3] = v[i][3] * gs[i]; }
        const int ck0 = k0, cn0 = n0; const int itn = it + ngw; const bool more = itn < nitems;
        if (more) { k0 = 64 * (itn / nblk); n0 = 64 * (itn % nblk);
#pragma unroll
            for (int i = 0; i < 16; ++i) { v[i] = *(const f32x4*)(W + (size_t)(k0 + lr + 4 * i) * N + n0 + lc); gs[i] = gain ? gain[k0 + lr + 4 * i] : 1.0f; } }
        LDS_WAIT(); asm volatile("" ::: "memory");
        const int cc = lane & 7;
        const int drow0 = (cn0 / blk) * dblk + doff + (cn0 % blk);
#pragma unroll
        for (int j = 0; j < 8; ++j) { const int n = (lane >> 3) + 8 * j; const LAS float* sp = scr + (8 * cc) * TR_LD + n;
            float t[8];
#pragma unroll
            for (int q = 0; q < 8; ++q) t[q] = sp[q * TR_LD];
            v4u o; o.x = pk2t(t[0], t[1]); o.y = pk2t(t[2], t[3]); o.z = pk2t(t[4], t[5]); o.w = pk2t(t[6], t[7]);
            *(v4u*)(WT + (size_t)(drow0 + n) * K + ck0 + 8 * cc) = o; }
        LDS_WAIT(); asm volatile("" ::: "memory");
        if (!more) break;
        it = itn;
    }
}

template <int W> __device__ __forceinline__ void pooled_block(const bf16* __restrict__ pbuf, bf16* __restrict__ pooled, int s0, int cv) {
    constexpr int RB = 8, LO = W / 2, HI = W - 1 - LO, NR = RB + W - 1;
    v4u raw[NR];
#pragma unroll
    for (int q = 0; q < NR; ++q) { const int r = s0 - LO + q; const int rc = r < 0 ? 0 : (r >= S_ ? S_ - 1 : r); raw[q] = *(const v4u*)(pbuf + (size_t)rc * PD + cv * 8); }
#pragma unroll
    for (int q = 0; q < NR; ++q) { const int r = s0 - LO + q; if (r < 0 || r >= S_) raw[q] = (v4u){0u, 0u, 0u, 0u}; }
    accv ra = {0.f, 0.f, 0.f, 0.f}, rb = {0.f, 0.f, 0.f, 0.f};
#pragma unroll
    for (int q = 0; q < W; ++q) { accv a, b; unpack8(raw[q], a, b); ra += a; rb += b; }
#pragma unroll
    for (int i = 0; i < RB; ++i) { const int s = s0 + i; int st = s - LO; st = st < 0 ? 0 : st; int en = s + HI + 1; en = en > S_ ? S_ : en; const float inv = 1.0f / (float)(en - st);
        accv sa, sb; unpack8(raw[i + LO], sa, sb);
        *(v4u*)(pooled + (size_t)s * PD + cv * 8) = pack8(ra * inv - sa, rb * inv - sb);
        if (i < RB - 1) { accv a, b, c, d; unpack8(raw[i + W], a, b); unpack8(raw[i], c, d); ra += a - c; rb += b - d; } }
}
struct Args { const float* in[19]; const int* pos; float* out; unsigned char* ws; int ph_lo, ph_hi; };
static_assert(sizeof(Args) == 19 * 8 + 8 + 8 + 8 + 8, "Args has no padding");

enum { IN_X = 0, IN_POS = 1, IN_F1N = 2, IN_F1G = 3, IN_F1U = 4, IN_F1D = 5, IN_MIXN = 6, IN_WIN = 7, IN_DECF = 8, IN_DECB = 9, IN_HNORM = 10, IN_POOLW = 11, IN_PSCALE = 12,
       IN_WOUT = 13, IN_F2N = 14, IN_F2G = 15, IN_F2U = 16, IN_F2D = 17, IN_FINN = 18 };
constexpr int NPHASE = 11;
#ifndef MK_DUP
#define MK_DUP (-1)
#endif
#ifndef MK_SUB
#define MK_SUB 0
#endif
#define SUBON(k) (!rep || MK_SUB == 0 || MK_SUB == (k))
#ifndef MK_PHASE_MASK
#define MK_PHASE_MASK 0x7ff
#endif

typedef const __attribute__((address_space(4))) Args* KArgs;
__device__ __forceinline__ KArgs kargs() { KArgs p = (KArgs)__builtin_amdgcn_kernarg_segment_ptr(); asm volatile("" : "+s"(p)); return p; }
#define GP(T, p) ((T*)(GAS T*)(p))
__device__ __forceinline__ void grid_sync(Frame& F) {
    KArgs ap = kargs(); XcdBarrier b; b.bar = (unsigned*)(GP(unsigned char, ap->ws) + WS_CTL) + CW_BAR; b.x = xb_xcc_id(); b.st = F.MISC + 8; xcd_barrier(b);
}

__global__ void __launch_bounds__(NWAVES * 64, 2) fwd_kernel(Args args) {
    extern __shared__ __attribute__((aligned(16))) unsigned char lds[];
    Frame F;
    F.lds = (LAS unsigned char*)lds;
    F.MISC = (volatile LAS unsigned*)(F.lds + MISC_OFF);
    F.tid = threadIdx.x; F.lane = F.tid & 63; F.wave = __builtin_amdgcn_readfirstlane(F.tid >> 6);
    F.G = gridDim.x;
    if (F.tid < 64) F.MISC[F.tid] = 0u;
    __syncthreads();
    { KArgs ap = kargs(); (void)xcd_barrier_post((unsigned*)(GP(unsigned char, ap->ws) + WS_CTL) + CW_BAR, F.MISC + 8); }
    const int lo = args.ph_lo, hi = args.ph_hi;
#define IN(k) (lo <= (k) && (k) < hi)
#define PHON(k) (((MK_PHASE_MASK) >> (k)) & 1)
#define SEAM(k) do { if (IN(k) && IN((k) + 1)) grid_sync(F); } while (0)
#if MK_DUP == 0
#define RL0 for (int rep = 0; rep < 2; ++rep)
#else
#define RL0 if (const int rep = 0; true)
#endif
#if MK_DUP == 1
#define RL1 for (int rep = 0; rep < 2; ++rep)
#else
#define RL1 if (const int rep = 0; true)
#endif
#if MK_DUP == 2
#define RL2 for (int rep = 0; rep < 2; ++rep)
#else
#define RL2 if (const int rep = 0; true)
#endif
#if MK_DUP == 3
#define RL3 for (int rep = 0; rep < 2; ++rep)
#else
#define RL3 if (const int rep = 0; true)
#endif
#if MK_DUP == 4
#define RL4 for (int rep = 0; rep < 2; ++rep)
#else
#define RL4 if (const int rep = 0; true)
#endif
#if MK_DUP == 5
#define RL5 for (int rep = 0; rep < 2; ++rep)
#else
#define RL5 if (const int rep = 0; true)
#endif
#if MK_DUP == 6
#define RL6 for (int rep = 0; rep < 2; ++rep)
#else
#define RL6 if (const int rep = 0; true)
#endif
#if MK_DUP == 7
#define RL7 for (int rep = 0; rep < 2; ++rep)
#else
#define RL7 if (const int rep = 0; true)
#endif
#if MK_DUP == 8
#define RL8 for (int rep = 0; rep < 2; ++rep)
#else
#define RL8 if (const int rep = 0; true)
#endif
#if MK_DUP == 9
#define RL9 for (int rep = 0; rep < 2; ++rep)
#else
#define RL9 if (const int rep = 0; true)
#endif
#if MK_DUP == 10
#define RL10 for (int rep = 0; rep < 2; ++rep)
#else
#define RL10 if (const int rep = 0; true)
#endif
#define PHASE(k) if (PHON(k) && IN(k)) RL##k
#define PHASE_ENV KArgs ap = kargs(); unsigned char* ws = GP(unsigned char, ap->ws); float* rsq = (float*)(ws + WS_CTL) + CW_RSQ; float* xres = GP(float, ap->out); bf16* xb = (bf16*)(ws + WS_XB); \
    float* const dum_rs = (float*)(ws + WS_TAB + 65536); (void)rsq; (void)xres; (void)xb; (void)dum_rs; if (rep) grid_sync(F)
#define AIN(k) GP(const float, ap->in[k])
    const int gw = blockIdx.x * NWAVES + F.wave, NGW = F.G * NWAVES;
    const int gt = blockIdx.x * (NWAVES * 64) + F.tid, NGT = F.G * NWAVES * 64;

    PHASE(0) { PHASE_ENV;
        tr_matrix(F, AIN(IN_F1G), DM, FF, AIN(IN_F1N), (bf16*)(ws + WS_WGU1), 128, 256, 0, gw, NGW);
        tr_matrix(F, AIN(IN_F1U), DM, FF, AIN(IN_F1N), (bf16*)(ws + WS_WGU1), 128, 256, 128, gw, NGW);
        tr_matrix(F, AIN(IN_F1D), FF, DM, nullptr, (bf16*)(ws + WS_WD1), DM, 0, 0, gw, NGW);
        tr_matrix(F, AIN(IN_F2G), DM, FF, AIN(IN_F2N), (bf16*)(ws + WS_WGU2), 128, 256, 0, gw, NGW);
        tr_matrix(F, AIN(IN_F2U), DM, FF, AIN(IN_F2N), (bf16*)(ws + WS_WGU2), 128, 256, 128, gw, NGW);
        tr_matrix(F, AIN(IN_F2D), FF, DM, nullptr, (bf16*)(ws + WS_WD2), DM, 0, 0, gw, NGW);
#pragma unroll 1
        for (int g = 0; g < 4; ++g) tr_matrix(F, AIN(IN_POOLW) + (size_t)g * 512 * 512, 512, 512, nullptr, (bf16*)(ws + WS_WPOOL) + (size_t)g * 512 * 512, 512, 0, 0, gw, NGW);
        const float* x = AIN(IN_X);
        for (int m = gw; m < S_; m += NGW) {
            const f32x4* xr = (const f32x4*)(x + (size_t)m * DM) + F.lane; float ss = 0.f;
            f32x4 xv[16];
#pragma unroll
            for (int j = 0; j < 16; ++j) xv[j] = xr[64 * j];
            asm volatile("" ::: "memory");
#pragma unroll
            for (int j = 0; j < 16; ++j) { const f32x4 a = xv[j];
                ss += (a[0] * a[0] + a[1] * a[1]) + (a[2] * a[2] + a[3] * a[3]);
                v2u pa; pa.x = pk2(a[0], a[1]); pa.y = pk2(a[2], a[3]);
                *((v2u*)(xb + (size_t)m * DM) + F.lane + 64 * j) = pa; }
            ss = wave_sum(ss);
            if (F.lane == 0) rsq[m] = ss;
        }
        if (gt < 16) ((float*)(ws + WS_TAB))[gt] = log2_sigmoid((gt < 8 ? AIN(IN_DECF) : AIN(IN_DECB))[gt & 7]);
        float* cst = (float*)(ws + WS_CS); const int* pos = GP(const int, ap->pos);
        for (int t = gt; t < S_ * 128; t += NGT) { const int s = t >> 7, i = t & 127;
            const float pw = (float)pow(10000.0, (double)((float)i * (1.0f / 128.0f))); const float fr = 1.0f / pw;
            const float ang = (float)pos[s] * fr;
            const double rev = (double)ang * 0.15915494309189533577; const float fr_rev = (float)(rev - rint(rev));
            cst[t] = __builtin_amdgcn_cosf(fr_rev); cst[(size_t)S_ * 128 + t] = __builtin_amdgcn_sinf(fr_rev); }
    }
    SEAM(0);

    PHASE(1) { PHASE_ENV;
        pg8::Gemm g{xb, (const bf16*)(ws + WS_WGU1), DM, DM, DM}; pg8::SchedGrid S; S.init(S_ / 256, 2 * FF / 256, F.G, (int)blockIdx.x, DM, DM);
        EpiGateUp E{rsq, (bf16*)(ws + WS_ACT)};
        pg8::gemm_phase(F.lds + RING_OFF, g, S, E);
        if (!rep) {
            const int nun = (S_ / 256) * (2 * FF / 256), rem = nun % F.G, first = rem, nidle = F.G - first;
            if ((int)blockIdx.x >= first) { const int gwi = ((int)blockIdx.x - first) * NWAVES + F.wave, ngw = nidle * NWAVES;
                tr_matrix(F, AIN(IN_WIN), DM, PROJ, AIN(IN_MIXN), (bf16*)(ws + WS_WIN), PROJ, 0, 0, gwi, ngw);
                tr_matrix(F, AIN(IN_WOUT), DM, DM, nullptr, (bf16*)(ws + WS_WOUT), DM, 0, 0, gwi, ngw); }
        }
    }
    SEAM(1);
    PHASE(2) { PHASE_ENV;
        pg8::Gemm g{(const bf16*)(ws + WS_ACT), (const bf16*)(ws + WS_WD1), FF, FF, FF}; pg8::SchedGrid S; S.init(S_ / 256, DM / 256, F.G, (int)blockIdx.x, FF, FF);
        EpiResid E{rep ? (bf16*)(ws + WS_ACAT) : xb, rep ? dum_rs : rsq + S_, 0.5f};
        pg8::gemm_phase(F.lds + RING_OFF, g, S, E);
    }
    SEAM(2);
    PHASE(3) { PHASE_ENV;
        pg8::Gemm g{xb, (const bf16*)(ws + WS_WIN), DM, DM, DM}; pg8::SchedGrid S; S.init(S_ / 256, PROJ / 256, F.G, (int)blockIdx.x, DM, DM);
        EpiZ E{rsq + S_, (const float*)(ws + WS_CS), (const float*)(ws + WS_TAB), (bf16*)(ws + WS_QROW), (bf16*)(ws + WS_KROW), (bf16*)(ws + WS_KDT), (bf16*)(ws + WS_GS), (bf16*)(ws + WS_PB),
               (bf16*)(ws + WS_ACAT), (bf16*)(ws + WS_BCAT)};
        pg8::gemm_phase(F.lds + RING_OFF, g, S, E);
    }
    SEAM(3);
    PHASE(4) { PHASE_ENV;
        if (SUBON(1)) {   const bf16* pbuf = (const bf16*)(ws + WS_PB); bf16* pooled = (bf16*)(ws + WS_POOLED);
            for (int t = gt; t < (S_ / 8) * (PD / 8); t += NGT) { const int s0 = (t >> 8) * 8, cv = t & 255, grp = cv >> 6;
                if (grp == 0) pooled_block<2>(pbuf, pooled, s0, cv); else if (grp == 1) pooled_block<4>(pbuf, pooled, s0, cv);
                else if (grp == 2) pooled_block<8>(pbuf, pooled, s0, cv); else pooled_block<16>(pbuf, pooled, s0, cv); }
            VM_WAIT(); __syncthreads();
        }
        if (SUBON(2)) {   pg8::Gemm g{(const bf16*)(ws + WS_BCAT), (const bf16*)(ws + WS_KDT), KCAT, S_, CH}; SchedKV S{F.G, (int)blockIdx.x};
            EpiKV E{(bf16*)(ws + WS_BCAT)};
            pg8::gemm_phase(F.lds + RING_OFF, g, S, E); }
        if (SUBON(3)) {   pg8::Gemm g{(const bf16*)(ws + WS_QROW), (const bf16*)(ws + WS_KROW), RD, RD, HD}; SchedS S{F.G, (int)blockIdx.x};
            EpiS E{(const float*)(ws + WS_TAB), (bf16*)(ws + WS_ACAT)};
            pg8::gemm_phase(F.lds + RING_OFF, g, S, E); }
    }
    SEAM(4);
    PHASE(5) { PHASE_ENV;
        if (!rep) {   bf16* bcat = (bf16*)(ws + WS_BCAT);
            for (int t = gt; t < 2 * NH * HD * (HD / 8); t += NGT) { const int dir = t >> 16, rem = t & 65535, h = rem >> 13, e = (rem >> 5) & 255, dv = rem & 31;
                const float l2 = ((const float*)(ws + WS_TAB))[dir * 8 + h]; const float dC = fast_exp2(l2 * (float)CH);
                bf16* p0 = bcat + ((size_t)(h * NCH) * 256 + e) * KCAT + 256 + 256 * dir + dv * 8; const size_t cstep = (size_t)256 * KCAT;
                float run[8];
#pragma unroll
                for (int j = 0; j < 8; ++j) run[j] = 0.f;
#pragma unroll 1
                for (int cb = 0; cb < NCH; cb += 8) { v4u kv[8];
#pragma unroll
                    for (int q = 0; q < 8; ++q) { const int c = dir ? (NCH - 1 - (cb + q)) : (cb + q); kv[q] = *(const v4u*)(p0 + (size_t)c * cstep); }
#pragma unroll
                    for (int q = 0; q < 8; ++q) { const int c = dir ? (NCH - 1 - (cb + q)) : (cb + q);
                        v4u o; o.x = pk2(run[0], run[1]); o.y = pk2(run[2], run[3]); o.z = pk2(run[4], run[5]); o.w = pk2(run[6], run[7]);
                        *(v4u*)(p0 + (size_t)c * cstep) = o;
                        run[0] = run[0] * dC + bf2f(kv[q].x & 0xffffu); run[1] = run[1] * dC + bf2f(kv[q].x >> 16); run[2] = run[2] * dC + bf2f(kv[q].y & 0xffffu); run[3] = run[3] * dC + bf2f(kv[q].y >> 16);
                        run[4] = run[4] * dC + bf2f(kv[q].z & 0xffffu); run[5] = run[5] * dC + bf2f(kv[q].z >> 16); run[6] = run[6] * dC + bf2f(kv[q].w & 0xffffu); run[7] = run[7] * dC + bf2f(kv[q].w >> 16); } } }
            VM_WAIT(); __syncthreads();
        }
        {   pg8::Gemm g{(const bf16*)(ws + WS_POOLED), (const bf16*)(ws + WS_WPOOL), PD, 512, 512}; SchedPool S{F.G, (int)blockIdx.x};
            EpiPool E{AIN(IN_PSCALE), (bf16*)(ws + WS_MIX)};
            pg8::gemm_phase(F.lds + RING_OFF, g, S, E); }
    }
    SEAM(5);
    PHASE(6) { PHASE_ENV;
        pg8::Gemm g{(const bf16*)(ws + WS_ACAT), (const bf16*)(ws + WS_BCAT), KCAT, KCAT, KCAT}; SchedOut S{F.G, (int)blockIdx.x};
        EpiOut E{AIN(IN_HNORM), (const bf16*)(ws + WS_GS), (bf16*)(ws + WS_MIX), (LAS float*)(F.lds + EPI_SCR_OFF)};
        pg8::gemm_phase(F.lds + RING_OFF, g, S, E);
    }
    SEAM(6);
    PHASE(7) { PHASE_ENV;
        pg8::Gemm g{(const bf16*)(ws + WS_MIX), (const bf16*)(ws + WS_WOUT), DM, DM, DM}; pg8::SchedGrid S; S.init(S_ / 256, DM / 256, F.G, (int)blockIdx.x, DM, DM);
        EpiResid E{rep ? (bf16*)(ws + WS_ACAT) : xb, rep ? dum_rs : rsq + 2 * S_, 1.0f};
        pg8::gemm_phase(F.lds + RING_OFF, g, S, E);
    }
    SEAM(7);
    PHASE(8) { PHASE_ENV;
        pg8::Gemm g{xb, (const bf16*)(ws + WS_WGU2), DM, DM, DM}; pg8::SchedGrid S; S.init(S_ / 256, 2 * FF / 256, F.G, (int)blockIdx.x, DM, DM);
        EpiGateUp E{rsq + 2 * S_, (bf16*)(ws + WS_ACT)};
        pg8::gemm_phase(F.lds + RING_OFF, g, S, E);
    }
    SEAM(8);
    PHASE(9) { PHASE_ENV;
        pg8::Gemm g{(const bf16*)(ws + WS_ACT), (const bf16*)(ws + WS_WD2), FF, FF, FF}; pg8::SchedGrid S; S.init(S_ / 256, DM / 256, F.G, (int)blockIdx.x, FF, FF);
        EpiResid E{rep ? (bf16*)(ws + WS_WGU1) : xb, rep ? dum_rs : rsq + 3 * S_, 0.5f};
        pg8::gemm_phase(F.lds + RING_OFF, g, S, E);
    }
    SEAM(9);
    PHASE(10) { PHASE_ENV;
        const float* fn = AIN(IN_FINN);
        const unsigned tmo = __hip_atomic_load((unsigned*)(ws + WS_CTL) + CW_BAR + XB_TMO, RLX_AGENT);
        for (int m = gw; m < S_; m += NGW) { float rs = 1.0f / sqrtf(rsq[3 * S_ + m] * (1.0f / DM) + EPS);
            if (tmo) rs = __builtin_nanf("");
            const v4u* xr = (const v4u*)(xb + (size_t)m * DM) + F.lane; f32x4* orow = (f32x4*)(xres + (size_t)m * DM);
            v4u xw[8];
#pragma unroll
            for (int j = 0; j < 8; ++j) xw[j] = xr[64 * j];
            asm volatile("" ::: "memory");
#pragma unroll
            for (int j = 0; j < 8; ++j) { accv a, b; unpack8(xw[j], a, b);
                const f32x4 g0 = *((const f32x4*)fn + 2 * (F.lane + 64 * j)), g1 = *((const f32x4*)fn + 2 * (F.lane + 64 * j) + 1);
                orow[2 * (F.lane + 64 * j)] = a * rs * g0; orow[2 * (F.lane + 64 * j) + 1] = b * rs * g1; } }
    }
#undef IN
#undef SEAM
}

#ifndef MK_N_LAUNCHES
#define MK_N_LAUNCHES 1
#endif
extern "C" void kernel_launch(void* const* d_in, const int* in_sizes, int n_in, void* d_out, int out_size, void* d_ws, size_t ws_size, hipStream_t stream) {
    static int grid = 0;
    if (grid == 0) {
        if (n_in != 19 || in_sizes[0] != S_ * DM || out_size != S_ * DM || ws_size < WS_END2) { fprintf(stderr, "kernel_launch: unexpected shapes (n_in %d, in0 %d, out %d, ws %zu); nothing launched\n", n_in, n_in > 0 ? in_sizes[0] : -1, out_size, ws_size); grid = -1; return; }
        int dev = 0, cus = 0, per_cu = 0;
        if (hipGetDevice(&dev) != hipSuccess || hipDeviceGetAttribute(&cus, hipDeviceAttributeMultiprocessorCount, dev) != hipSuccess) { fprintf(stderr, "kernel_launch: device query failed\n"); grid = -1; return; }
        if (hipFuncSetAttribute((const void*)fwd_kernel, hipFuncAttributeMaxDynamicSharedMemorySize, LDS_BYTES) != hipSuccess) { fprintf(stderr, "kernel_launch: hipFuncSetAttribute failed\n"); grid = -1; return; }
        if (hipOccupancyMaxActiveBlocksPerMultiprocessor(&per_cu, (const void*)fwd_kernel, NWAVES * 64, LDS_BYTES) != hipSuccess || per_cu < 1) { fprintf(stderr, "kernel_launch: occupancy query reports %d workgroups per CU\n", per_cu); per_cu = 1; }
        (void)hipGetLastError();
        grid = cus;
    }
    if (grid < 0) return;
    if (hipMemsetAsync((char*)d_ws + WS_CTL, 0, CTL_ZERO_BYTES, stream) != hipSuccess) { fprintf(stderr, "kernel_launch: memset failed\n"); return; }
    Args a{};
    for (int i = 0; i < 19; ++i) a.in[i] = (const float*)d_in[i];
    a.pos = (const int*)d_in[IN_POS]; a.out = (float*)d_out; a.ws = (unsigned char*)d_ws;
#if MK_N_LAUNCHES == 1
    a.ph_lo = 0; a.ph_hi = NPHASE;
    hipLaunchKernelGGL(fwd_kernel, dim3(grid), dim3(NWAVES * 64), LDS_BYTES, stream, a);
#else
    for (int p = 0; p < NPHASE; ++p) { a.ph_lo = p; a.ph_hi = p + 1; hipLaunchKernelGGL(fwd_kernel, dim3(grid), dim3(NWAVES * 64), LDS_BYTES, stream, a); }
#endif
    const hipError_t le = hipPeekAtLastError();
    if (le != hipSuccess) fprintf(stderr, "kernel_launch: launch failed: %s\n", hipGetErrorName(le));
}
```

```cpp
#include <hip/hip_runtime.h>
#include <cstdio>
#include <cstdint>

namespace pg8 {
#define PG8_LAS __attribute__((address_space(3)))
typedef unsigned short bf16_t;
typedef short bf16x8 __attribute__((ext_vector_type(8)));
typedef float f32x4 __attribute__((ext_vector_type(4)));
typedef unsigned u32x4 __attribute__((ext_vector_type(4)));
constexpr int BM = 256, BK = 64, HALF = 128, HTB = HALF * BK * 2  , STAGE_BYTES = 8 * HTB, NXCD = 8, WGM = 8;

__host__ __device__ __forceinline__ int lds_byte(int r, int c) { const int st = (r >> 4) * 2 + (c >> 5), rr = r & 15, cc = c & 31, ob = rr * 64 + cc * 2; return st * 1024 + (ob ^ (((ob >> 9) & 1) << 5)); }
__host__ __device__ __forceinline__ void stage_rc(int b, int& R, int& C) { const int st = b / 1024, sb = b % 1024, swz = sb ^ (((sb >> 9) & 1) << 5); R = (st >> 1) * 16 + swz / 64; C = (st & 1) * 32 + (swz % 64) / 2; }
__host__ __device__ __forceinline__ int perm32(int rho) { const int n = rho >> 4, i = rho & 15; return 8 * (i >> 2) + 4 * n + (i & 3); }

struct Unit { int pm, pn, z; };
struct Gemm { const bf16_t* A; const bf16_t* Bt; int lda, ldb, K; };

struct SchedGrid {
    int nM, nN, nwg, G, c, wgm; size_t astep, bstep;
    __device__ __forceinline__ void init(int nM_, int nN_, int G_, int c_, int lda, int ldb, int wgm_ = WGM) { nM = nM_; nN = nN_; nwg = nM * nN; G = G_; c = c_; wgm = wgm_; astep = (size_t)BM * lda * 2; bstep = (size_t)BM * ldb * 2; }
    __device__ __forceinline__ bool next(int i, Unit& u) const {
        const long L = (long)i * G + c; if (L >= nwg) return false;
        int wgid = (int)L; { const int q = nwg / NXCD, r = nwg % NXCD, xcd = wgid % NXCD, off = wgid / NXCD; wgid = (xcd < r ? xcd * (q + 1) : r * (q + 1) + (xcd - r) * q) + off; }
        const int nig = wgm * nN, gid = wgid / nig, fm = gid * wgm, gsz = (nM - fm) < wgm ? (nM - fm) : wgm;
        u.pm = fm + ((wgid % nig) % gsz); u.pn = (wgid % nig) / gsz; u.z = 0; return true;
    }
    __device__ __forceinline__ size_t a_off(const Unit& u) const { return (size_t)u.pm * astep; }
    __device__ __forceinline__ size_t b_off(const Unit& u) const { return (size_t)u.pn * bstep; }
};

__device__ __forceinline__ unsigned cvt_pk_bf16(float lo, float hi) { unsigned r; asm volatile("v_cvt_pk_bf16_f32 %0, %1, %2" : "=v"(r) : "v"(lo), "v"(hi)); return r; }

template <class Epi, class Sched>
__device__ __forceinline__ void gemm_phase(PG8_LAS unsigned char* lds, const Gemm g, const Sched& S, const Epi& E) {
    const int tid = threadIdx.x, wid = __builtin_amdgcn_readfirstlane(tid >> 6), lane = tid & 63, wr = wid >> 2, wc = wid & 3, fr = lane & 15, fq = lane >> 4;
    int nt = g.K / BK; asm volatile("" : "+s"(nt));
    unsigned voffA[2], voffB[2];
#pragma unroll
    for (int i = 0; i < 2; ++i) { int R, C; stage_rc(tid * 16 + i * 8192, R, C); const int Rb = (R & ~31) + perm32(R & 31);
        voffA[i] = (unsigned)(R * g.lda + C) * 2u; voffB[i] = (unsigned)(Rb * g.ldb + C) * 2u; }
    const size_t kstep = (size_t)(BK * 2);
    const size_t hstepA = (size_t)HALF * g.lda * 2, hstepB = (size_t)HALF * g.ldb * 2;
    const unsigned ldsw = (unsigned)wid * 1024u;
    const int aoff = lds_byte(wr * 64 + fr, fq * 8), boff = lds_byte(wc * 32 + fr, fq * 8);
#define PG8_SA(b, h) (((b) * 2 + (h)) * HTB)
#define PG8_SB(b, h) ((4 + (b) * 2 + (h)) * HTB)
#define PG8_STAGE(bufoff, gbase, voff) do { _Pragma("unroll") for (int _i = 0; _i < 2; ++_i) \
        __builtin_amdgcn_global_load_lds((const unsigned*)((const char*)(gbase) + (voff)[_i]), (PG8_LAS unsigned*)(lds + (bufoff) + ldsw + _i * 8192), 16, 0, 0); } while (0)
#define PG8_LDA(dst, b, h) do { _Pragma("unroll") for (int m = 0; m < 4; ++m) _Pragma("unroll") for (int k = 0; k < 2; ++k) dst[m][k] = *(const PG8_LAS bf16x8*)(lds + PG8_SA(b, h) + aoff + m * 2048 + k * 1024); } while (0)
#define PG8_LDB(dst, b, h) do { _Pragma("unroll") for (int n = 0; n < 2; ++n) _Pragma("unroll") for (int k = 0; k < 2; ++k) dst[n][k] = *(const PG8_LAS bf16x8*)(lds + PG8_SB(b, h) + boff + n * 2048 + k * 1024); } while (0)
#define PG8_MMA(ai, bj, At, Bt) do { __builtin_amdgcn_s_setprio(1); _Pragma("unroll") for (int m = 0; m < 4; ++m) _Pragma("unroll") for (int n = 0; n < 2; ++n) _Pragma("unroll") for (int k = 0; k < 2; ++k) \
        acc[ai][bj][m][n] = __builtin_amdgcn_mfma_f32_16x16x32_bf16(Bt[n][k], At[m][k], acc[ai][bj][m][n], 0, 0, 0); __builtin_amdgcn_s_setprio(0); } while (0)
#define PG8_WAIT_V(n) asm volatile("s_waitcnt vmcnt(" #n ")" ::: "memory")
#define PG8_WAIT_L(n) asm volatile("s_waitcnt lgkmcnt(" #n ")" ::: "memory")
#define PG8_BAR __builtin_amdgcn_s_barrier()
#define PG8_SCHED __builtin_amdgcn_sched_barrier(0)
    Unit cur, nxt; int ui = 0;
    if (!S.next(0, cur)) return;
    f32x4 acc[2][2][4][2];
#pragma unroll
    for (int a = 0; a < 2; ++a)
#pragma unroll
        for (int b = 0; b < 2; ++b)
#pragma unroll
            for (int m = 0; m < 4; ++m)
#pragma unroll
                for (int n = 0; n < 2; ++n) acc[a][b][m][n] = (f32x4){0.f, 0.f, 0.f, 0.f};
    bf16x8 At[4][2], B0[2][2], B1[2][2];
    const char* cA = (const char*)g.A + S.a_off(cur); const char* cB = (const char*)g.Bt + S.b_off(cur);
    PG8_STAGE(PG8_SB(0, 0), cB, voffB); PG8_STAGE(PG8_SB(0, 1), cB + hstepB, voffB); PG8_STAGE(PG8_SA(0, 0), cA, voffA); PG8_STAGE(PG8_SA(0, 1), cA + hstepA, voffA);
    if (wr == 1) PG8_BAR;
    PG8_WAIT_V(2); PG8_BAR;
    PG8_STAGE(PG8_SB(1, 0), cB + kstep, voffB); PG8_STAGE(PG8_SA(1, 0), cA + kstep, voffA); PG8_STAGE(PG8_SB(1, 1), cB + hstepB + kstep, voffB);
    PG8_WAIT_V(6); PG8_BAR;
    for (;;) {
        const bool has_next = S.next(ui + 1, nxt);
        const char* nA = has_next ? (const char*)g.A + S.a_off(nxt) : cA; const char* nB = has_next ? (const char*)g.Bt + S.b_off(nxt) : cB;
        for (int t = 0; t < nt; t += 2) {
            const bool last = (t == nt - 2);
            const char* a1 = cA + (size_t)(t + 1) * kstep;
            const char* a2 = last ? nA : cA + (size_t)(t + 2) * kstep; const char* b2 = last ? nB : cB + (size_t)(t + 2) * kstep;
            const char* a3 = a2 + kstep; const char* b3 = b2 + kstep;
            PG8_LDB(B0, 0, 0); PG8_LDB(B1, 0, 1); PG8_SCHED; PG8_LDA(At, 0, 0); PG8_STAGE(PG8_SA(1, 1), a1 + hstepA, voffA);
            PG8_WAIT_V(8); PG8_WAIT_L(0); PG8_BAR; PG8_MMA(0, 0, At, B0); PG8_MMA(0, 1, At, B1); PG8_BAR; PG8_SCHED;
            PG8_LDA(At, 0, 1); PG8_STAGE(PG8_SB(0, 0), b2, voffB); PG8_STAGE(PG8_SB(0, 1), b2 + hstepB, voffB); PG8_STAGE(PG8_SA(0, 0), a2, voffA);
            PG8_WAIT_V(8); PG8_WAIT_L(0); PG8_BAR; PG8_MMA(1, 0, At, B0); PG8_MMA(1, 1, At, B1); PG8_BAR; PG8_SCHED;
            PG8_LDB(B0, 1, 0); PG8_LDB(B1, 1, 1); PG8_SCHED; PG8_LDA(At, 1, 0); PG8_STAGE(PG8_SA(0, 1), a2 + hstepA, voffA);
            PG8_WAIT_V(8); PG8_WAIT_L(0); PG8_BAR; PG8_MMA(0, 0, At, B0); PG8_MMA(0, 1, At, B1); PG8_BAR; PG8_SCHED;
            PG8_LDA(At, 1, 1); PG8_STAGE(PG8_SB(1, 0), b3, voffB); PG8_STAGE(PG8_SB(1, 1), b3 + hstepB, voffB); PG8_STAGE(PG8_SA(1, 0), a3, voffA);
            PG8_WAIT_V(8); PG8_WAIT_L(0); PG8_BAR; PG8_MMA(1, 0, At, B0); PG8_MMA(1, 1, At, B1); PG8_BAR; PG8_SCHED;
        }
        if (wr == 0) PG8_BAR;
        { int fr2 = fr, fq2 = fq; asm volatile("" : "+v"(fr2), "+v"(fq2));
          E(acc, cur, wr, wc, fr2, fq2); }
        if (!has_next) break;
#pragma unroll
        for (int a = 0; a < 2; ++a)
#pragma unroll
            for (int b = 0; b < 2; ++b)
#pragma unroll
                for (int m = 0; m < 4; ++m)
#pragma unroll
                    for (int n = 0; n < 2; ++n) acc[a][b][m][n] = (f32x4){0.f, 0.f, 0.f, 0.f};
        cur = nxt; cA = nA; cB = nB; ++ui;
        if (wr == 1) PG8_BAR;
    }
    PG8_WAIT_V(0);
    PG8_BAR;
#undef PG8_SA
#undef PG8_SB
#undef PG8_STAGE
#undef PG8_LDA
#undef PG8_LDB
#undef PG8_MMA
#undef PG8_WAIT_V
#undef PG8_WAIT_L
#undef PG8_BAR
#undef PG8_SCHED
}
}

constexpr int NWAVES = 8;
constexpr int S_ = 16384, DM = 4096, FF = 11008, PROJ = 10240, RD = 2048, NH = 8, HD = 256, CH = 256, NCH = S_ / CH, PD = 2048;
constexpr float EPS = 1e-6f;
constexpr int KCAT = 768;

constexpr size_t MiB = 1u << 20;
constexpr size_t WS_CTL = 0, CTL_ZERO_BYTES = 1 * MiB;
constexpr size_t WS_TAB = 1 * MiB;
constexpr size_t WS_CS = 2 * MiB;
constexpr size_t WS_WPOOL = 18 * MiB;
constexpr size_t WS_WIN = 20 * MiB, WS_WOUT = 100 * MiB, WS_WGU2 = 132 * MiB, WS_WD2 = 304 * MiB;
constexpr size_t WS_XB = 390 * MiB;
constexpr size_t WS_WGU1 = 518 * MiB, WS_WD1 = 690 * MiB, WS_ACT = 776 * MiB;
constexpr size_t WS_QROW = 518 * MiB, WS_KROW = 582 * MiB, WS_KDT = 646 * MiB  , WS_GS = 774 * MiB, WS_PB = 838 * MiB, WS_POOLED = 902 * MiB;
constexpr size_t WS_ACAT = 966 * MiB, WS_BCAT = 1158 * MiB, WS_END = 1350 * MiB;
constexpr size_t WS_MIX = 1350 * MiB, WS_END2 = 1478 * MiB;
static_assert(WS_WIN + (size_t)PROJ * DM * 2 <= WS_WOUT && WS_WOUT + (size_t)DM * DM * 2 <= WS_WGU2 && WS_WGU2 + (size_t)2 * FF * DM * 2 <= WS_WD2 && WS_WD2 + (size_t)DM * FF * 2 <= WS_XB, "weights map");
static_assert(WS_XB + (size_t)S_ * DM * 2 <= WS_WGU1 && WS_WGU1 + (size_t)2 * FF * DM * 2 <= WS_WD1 && WS_WD1 + (size_t)DM * FF * 2 <= WS_ACT && WS_ACT + (size_t)S_ * FF * 2 <= WS_END, "ffn map");
static_assert(WS_ACAT + (size_t)NH * S_ * KCAT * 2 <= WS_BCAT && WS_BCAT + (size_t)NH * NCH * HD * KCAT * 2 <= WS_END && WS_POOLED + (size_t)S_ * PD * 2 <= WS_ACAT, "mixer map");
constexpr int CW_BAR = 4096;
constexpr int CW_RSQ = 16384;

constexpr int RING_OFF = 0, RING_BYTES = 131072;
constexpr int LDS_BYTES = 147456;
constexpr int EPI_SCR_OFF = 135168;
constexpr int MISC_OFF = LDS_BYTES - 256;
constexpr int TR_LD = 65, TR_BYTES = 64 * TR_LD * 4;
static_assert(NWAVES * TR_BYTES <= EPI_SCR_OFF + 4096 && EPI_SCR_OFF + 4096 <= MISC_OFF, "LDS map");

#define GAS __attribute__((address_space(1)))
#define LAS __attribute__((address_space(3)))
typedef unsigned short bf16;
typedef unsigned v4u __attribute__((ext_vector_type(4)));
typedef unsigned v2u __attribute__((ext_vector_type(2)));
typedef float f32x4 __attribute__((ext_vector_type(4)));
typedef GAS unsigned gu32;
#define RLX_AGENT __ATOMIC_RELAXED, __HIP_MEMORY_SCOPE_AGENT
#define LDS_WAIT() asm volatile("s_waitcnt lgkmcnt(0)" ::: "memory")
#define VM_WAIT() asm volatile("s_waitcnt vmcnt(0)" ::: "memory")
__device__ __forceinline__ unsigned f2bf(float f) { unsigned u = __builtin_bit_cast(unsigned, f); return (u + 0x7fffu + ((u >> 16) & 1u)) >> 16; }
typedef __bf16 bf16x2_t __attribute__((ext_vector_type(2)));
typedef float f32x2_t __attribute__((ext_vector_type(2)));
__device__ __forceinline__ unsigned pk2t(float lo, float hi) { const f32x2_t v = {lo, hi}; return __builtin_bit_cast(unsigned, __builtin_convertvector(v, bf16x2_t)); }
__device__ __forceinline__ unsigned pk2(float lo, float hi) { return pg8::cvt_pk_bf16(lo, hi); }
__device__ __forceinline__ float bf2f(unsigned h) { return __builtin_bit_cast(float, h << 16); }
__device__ __forceinline__ float fast_exp2(float x) { return __builtin_amdgcn_exp2f(x); }
__device__ __forceinline__ float silu_f(float x) { return x * __builtin_amdgcn_rcpf(1.0f + fast_exp2(-1.4426950408889634f * x)); }
__device__ __forceinline__ float log2_sigmoid(float x) { return -log1pf(expf(-x)) * 1.4426950408889634f; }

#define XB_TMO      128
#define XB_XCNT(j)  (256  + 64 * (j))
#define XB_XSUB(j)  (1280 + 64 * (j))
#define XB_XGEN(j)  (2304 + 64 * (j))
#define XB_TOP      3328
#define XB_TOPGEN   3392
#define XCD_BAR_WORDS 3456
#define XB_SPIN_CAP (1u << 18)

__device__ __forceinline__ unsigned xb_ld(unsigned* p)              { return __hip_atomic_load(p, __ATOMIC_RELAXED, __HIP_MEMORY_SCOPE_AGENT); }
__device__ __forceinline__ unsigned xb_add(unsigned* p, unsigned v) { return __hip_atomic_fetch_add(p, v, __ATOMIC_RELAXED, __HIP_MEMORY_SCOPE_AGENT); }
__device__ __forceinline__ unsigned xb_xcc_id() { return (unsigned)__builtin_amdgcn_s_getreg((3 << 11) | 20) & 0xFu; }
#define XB_SPIN(cond, bar) do { unsigned _sp = 0; while (cond) { __builtin_amdgcn_s_sleep(1); \
    if ((++_sp & 255u) == 0u) { if (xb_ld(&(bar)[XB_TMO])) break; if (_sp > XB_SPIN_CAP) { atomicAdd(&(bar)[XB_TMO], 1u); break; } } } } while (0)

struct XcdBarrier {
    unsigned* bar; unsigned x;
    volatile LAS unsigned* st;
};
__device__ __forceinline__ XcdBarrier xcd_barrier_post(unsigned* bar, volatile LAS unsigned* st) {
    XcdBarrier b; b.bar = bar; b.x = xb_xcc_id(); b.st = st;
    if (threadIdx.x == 0) (void)xb_add(&bar[XB_XCNT(b.x)], 1u);
    return b;
}
__device__ __forceinline__ void xcd_barrier_complete(unsigned* bar, unsigned x, unsigned& nloc, unsigned& nx) {
    const unsigned G = gridDim.x * gridDim.y * gridDim.z;
    unsigned sum, cnt, mine, sp = 0u;
    for (;;) {
        sum = 0u; cnt = 0u; mine = 0u;
#pragma unroll
        for (unsigned j = 0; j < 16; ++j) { const unsigned c = xb_ld(&bar[XB_XCNT(j)]); sum += c; cnt += (c > 0u) ? 1u : 0u; mine = (j == x) ? c : mine; }
        if (sum == G) break;
        __builtin_amdgcn_s_sleep(1);
        if ((++sp & 255u) == 0u) { if (xb_ld(&bar[XB_TMO])) break; if (sp > XB_SPIN_CAP) { atomicAdd(&bar[XB_TMO], 1u); break; } }
    }
    nloc = mine > 0u ? mine : 1u; nx = cnt > 0u ? cnt : 1u;
}
__device__ __forceinline__ void xcd_barrier(const XcdBarrier& b) {
    asm volatile("s_waitcnt vmcnt(0)" ::: "memory");
    __syncthreads();
    if (threadIdx.x == 0) {
        unsigned* bar = b.bar;
        __builtin_amdgcn_s_waitcnt(0);
        unsigned nloc = b.st[0], nx = b.st[1];
        if (nloc == 0u) { xcd_barrier_complete(bar, b.x, nloc, nx); b.st[0] = nloc; b.st[1] = nx; }
        const unsigned old = xb_add(&bar[XB_XSUB(b.x)], 1u);
        const unsigned gen = old / nloc;
        if (old + 1u == (gen + 1u) * nloc) {
            __builtin_amdgcn_fence(__ATOMIC_RELEASE, "agent");
            asm volatile("s_waitcnt vmcnt(0)" ::: "memory");
            const unsigned og = xb_add(&bar[XB_TOP], 1u);
            const unsigned tg = og / nx;
            if (og + 1u == (tg + 1u) * nx) xb_add(&bar[XB_TOPGEN], 1u);
            else XB_SPIN(xb_ld(&bar[XB_TOPGEN]) == tg, bar);
            __builtin_amdgcn_fence(__ATOMIC_ACQUIRE, "agent");
            xb_add(&bar[XB_XGEN(b.x)], 1u);
            asm volatile("s_waitcnt vmcnt(0)" ::: "memory");
        } else {
            XB_SPIN(xb_ld(&bar[XB_XGEN(b.x)]) == gen, bar);
            __builtin_amdgcn_fence(__ATOMIC_ACQUIRE, "agent");
            asm volatile("s_waitcnt vmcnt(0)" ::: "memory");
        }
    }
    __syncthreads();
}

using pg8::Unit;
typedef pg8::f32x4 accv;

__device__ __forceinline__ v4u pack8(const accv& v0, const accv& v1) { v4u w; w.x = pk2(v0[0], v0[1]); w.y = pk2(v0[2], v0[3]); w.z = pk2(v1[0], v1[1]); w.w = pk2(v1[2], v1[3]); return w; }

struct EpiGateUp {
    static constexpr bool PERM = true;
    const float* rowsq; bf16* act;
    __device__ __forceinline__ void operator()(const accv (&acc)[2][2][4][2], const Unit& u, int wr, int wc, int fr, int fq) const {
        const int row0 = u.pm * 256 + wr * 64 + fr, col0 = u.pn * 128 + wc * 32 + 8 * fq;
#pragma unroll
        for (int ai = 0; ai < 2; ++ai)
#pragma unroll
            for (int m = 0; m < 4; ++m) { const int row = row0 + ai * 128 + m * 16; const float rs = 1.0f / sqrtf(rowsq[row] * (1.0f / DM) + EPS);
                accv o[2];
#pragma unroll
                for (int n = 0; n < 2; ++n)
#pragma unroll
                    for (int j = 0; j < 4; ++j) { const float g = acc[ai][0][m][n][j] * rs, up = acc[ai][1][m][n][j] * rs; o[n][j] = silu_f(g) * up; }
                *(v4u*)(act + (size_t)row * FF + col0) = pack8(o[0], o[1]); }
    }
};

__device__ __forceinline__ void unpack8(const v4u& w, accv& a, accv& b) { a[0] = bf2f(w.x & 0xffffu); a[1] = bf2f(w.x >> 16); a[2] = bf2f(w.y & 0xffffu); a[3] = bf2f(w.y >> 16);
    b[0] = bf2f(w.z & 0xffffu); b[1] = bf2f(w.z >> 16); b[2] = bf2f(w.w & 0xffffu); b[3] = bf2f(w.w >> 16); }
struct EpiResid {
    static constexpr bool PERM = true;
    bf16* xs; float* rowsq; float scale;
    __device__ __forceinline__ void operator()(const accv (&acc)[2][2][4][2], const Unit& u, int wr, int wc, int fr, int fq) const {
        const int row0 = u.pm * 256 + wr * 64 + fr, col0 = u.pn * 256 + wc * 32 + 8 * fq;
        v4u xo[2][4][2];
#pragma unroll
        for (int ai = 0; ai < 2; ++ai)
#pragma unroll
            for (int m = 0; m < 4; ++m)
#pragma unroll
                for (int bj = 0; bj < 2; ++bj) xo[ai][m][bj] = *(const v4u*)(xs + (size_t)(row0 + ai * 128 + m * 16) * DM + col0 + bj * 128);
        asm volatile("" ::: "memory");
#pragma unroll
        for (int ai = 0; ai < 2; ++ai)
#pragma unroll
            for (int m = 0; m < 4; ++m) { const int row = row0 + ai * 128 + m * 16; const size_t off = (size_t)row * DM + col0; float ss = 0.f;
#pragma unroll
                for (int bj = 0; bj < 2; ++bj) { accv v0, v1; unpack8(xo[ai][m][bj], v0, v1);
                    v0 = v0 + acc[ai][bj][m][0] * scale; v1 = v1 + acc[ai][bj][m][1] * scale;
                    ss += (v0[0] * v0[0] + v0[1] * v0[1]) + (v0[2] * v0[2] + v0[3] * v0[3]) + (v1[0] * v1[0] + v1[1] * v1[1]) + (v1[2] * v1[2] + v1[3] * v1[3]);
                    *(v4u*)(xs + off + bj * 128) = pack8(v0, v1); }
                ss += __shfl_xor(ss, 16); ss += __shfl_xor(ss, 32);
                if (fq == 0) atomicAdd(rowsq + row, ss); }
    }
};

__device__ __forceinline__ float dpp_xor1(float v) { return __builtin_bit_cast(float, __builtin_amdgcn_mov_dpp(__builtin_bit_cast(int, v), 0xB1, 0xF, 0xF, true)); }
__device__ __forceinline__ void tstore2(bf16* p, float x0, float x1, bool odd) {
    const float recv = dpp_xor1(odd ? x0 : x1);
    *(unsigned*)p = pk2(odd ? recv : x0, odd ? x1 : recv);
}
struct EpiZ {
    static constexpr bool PERM = true;
    const float* rowsq; const float* cs; const float* l2tab;
    bf16 *qrow, *krow, *kdt, *gs, *pb, *acat, *bcat;
    __device__ __forceinline__ void operator()(const accv (&acc)[2][2][4][2], const Unit& u, int wr, int wc, int fr, int fq) const {
        const int type = u.pn >> 3, h = u.pn & 7, c = u.pm;
        const int i0 = wr * 64 + fr, d1 = wc * 32 + 8 * fq;
        const bool odd = (fr & 1) != 0;
        float rsv[2][4];
#pragma unroll
        for (int ai = 0; ai < 2; ++ai)
#pragma unroll
            for (int m = 0; m < 4; ++m) rsv[ai][m] = rowsq[c * 256 + i0 + ai * 128 + m * 16];
#pragma unroll
        for (int ai = 0; ai < 2; ++ai)
#pragma unroll
            for (int m = 0; m < 4; ++m) rsv[ai][m] = 1.0f / sqrtf(rsv[ai][m] * (1.0f / DM) + EPS);
        if (type <= 1) {
            float l2a = l2tab[h], l2b = l2tab[8 + h];
            accv tc[2][2], ts[2][2];
            { const size_t o = (size_t)(c * 256 + i0) * 128 + d1; tc[0][0] = *(const accv*)(cs + o); tc[0][1] = *(const accv*)(cs + o + 4); ts[0][0] = *(const accv*)(cs + (size_t)S_ * 128 + o); ts[0][1] = *(const accv*)(cs + (size_t)S_ * 128 + o + 4); }
#pragma unroll
            for (int ai = 0; ai < 2; ++ai)
#pragma unroll
                for (int m = 0; m < 4; ++m) { const int g = ai * 4 + m, cb = g & 1, i = i0 + ai * 128 + m * 16, s = c * 256 + i;
                    if (g < 7) { const int in = i0 + ((g + 1) >> 2) * 128 + ((g + 1) & 3) * 16; const size_t o = (size_t)(c * 256 + in) * 128 + d1;
                        tc[cb ^ 1][0] = *(const accv*)(cs + o); tc[cb ^ 1][1] = *(const accv*)(cs + o + 4); ts[cb ^ 1][0] = *(const accv*)(cs + (size_t)S_ * 128 + o); ts[cb ^ 1][1] = *(const accv*)(cs + (size_t)S_ * 128 + o + 4); }
                    const float rs = rsv[ai][m];
                    accv r1[2], r2[2];
                    r1[0] = acc[ai][0][m][0] * tc[cb][0] - acc[ai][1][m][0] * ts[cb][0]; r1[1] = acc[ai][0][m][1] * tc[cb][1] - acc[ai][1][m][1] * ts[cb][1];
                    r2[0] = acc[ai][0][m][0] * ts[cb][0] + acc[ai][1][m][0] * tc[cb][0]; r2[1] = acc[ai][0][m][1] * ts[cb][1] + acc[ai][1][m][1] * tc[cb][1];
                    if (type == 0) {
                        const size_t o = (size_t)s * RD + h * 256 + d1;
                        *(v4u*)(qrow + o) = pack8(r1[0] * rs, r1[1] * rs); *(v4u*)(qrow + o + 128) = pack8(r2[0] * rs, r2[1] * rs);
                        const float sf = rs * fast_exp2(l2a * (float)(i + 1)), sb = rs * fast_exp2(l2b * (float)(CH - i));
                        const size_t oa = ((size_t)h * S_ + s) * KCAT + 256 + d1;
                        *(v4u*)(acat + oa) = pack8(r1[0] * sf, r1[1] * sf); *(v4u*)(acat + oa + 128) = pack8(r2[0] * sf, r2[1] * sf);
                        *(v4u*)(acat + oa + 256) = pack8(r1[0] * sb, r1[1] * sb); *(v4u*)(acat + oa + 384) = pack8(r2[0] * sb, r2[1] * sb);
                    } else {
                        const float rk = rs * 0.0625f;
                        const size_t o = (size_t)s * RD + h * 256 + d1;
                        *(v4u*)(krow + o) = pack8(r1[0] * rk, r1[1] * rk); *(v4u*)(krow + o + 128) = pack8(r2[0] * rk, r2[1] * rk);
                        const float sf = rk * fast_exp2(l2a * (float)(CH - 1 - i)), sb = rk * fast_exp2(l2b * (float)i);
                        bf16* tf = kdt + ((size_t)h * 256 + d1 + (odd ? 1 : 0)) * S_ + s - (odd ? 1 : 0); bf16* tb = tf + (size_t)RD * S_;
#pragma unroll
                        for (int n = 0; n < 2; ++n)
#pragma unroll
                            for (int j = 0; j < 4; j += 2) { const size_t t = (size_t)(4 * n + j) * S_;
                                tstore2(tf + t, r1[n][j] * sf, r1[n][j + 1] * sf, odd); tstore2(tf + t + (size_t)128 * S_, r2[n][j] * sf, r2[n][j + 1] * sf, odd);
                                tstore2(tb + t, r1[n][j] * sb, r1[n][j + 1] * sb, odd); tstore2(tb + t + (size_t)128 * S_, r2[n][j] * sb, r2[n][j + 1] * sb, odd); }
                    }
                    asm volatile("" : "+v"(l2a), "+v"(l2b) :: "memory"); }
        } else if (type == 2) {
            bf16* base = bcat + ((size_t)(h * NCH + c) * 256 + d1 + (odd ? 1 : 0)) * KCAT - (odd ? 1 : 0);
#pragma unroll
            for (int ai = 0; ai < 2; ++ai)
#pragma unroll
                for (int m = 0; m < 4; ++m) { const int i = i0 + ai * 128 + m * 16; const float rs = rsv[ai][m];
#pragma unroll
                    for (int bj = 0; bj < 2; ++bj)
#pragma unroll
                        for (int n = 0; n < 2; ++n)
#pragma unroll
                            for (int j = 0; j < 4; j += 2) tstore2(base + (size_t)(bj * 128 + 4 * n + j) * KCAT + i, acc[ai][bj][m][n][j] * rs, acc[ai][bj][m][n][j + 1] * rs, odd); }
        } else {
            bf16* dst = (type == 3) ? gs : pb;
#pragma unroll
            for (int ai = 0; ai < 2; ++ai)
#pragma unroll
                for (int m = 0; m < 4; ++m) { const int i = i0 + ai * 128 + m * 16, s = c * 256 + i; const float rs = rsv[ai][m];
#pragma unroll
                    for (int bj = 0; bj < 2; ++bj) { accv v0 = acc[ai][bj][m][0] * rs, v1 = acc[ai][bj][m][1] * rs;
                        if (type == 3) {
#pragma unroll
                            for (int j = 0; j < 4; ++j) { v0[j] = silu_f(v0[j]); v1[j] = silu_f(v1[j]); } }
                        *(v4u*)(dst + (size_t)s * RD + h * 256 + bj * 128 + d1) = pack8(v0, v1); } }
        }
    }
};

struct EpiKV {
    static constexpr bool PERM = true;
    bf16* bcat;
    __device__ __forceinline__ void operator()(const accv (&acc)[2][2][4][2], const Unit& u, int wr, int wc, int fr, int fq) const {
        bf16* base = bcat + ((size_t)(u.pn * NCH + u.pm) * 256) * KCAT + 256 + 256 * u.z + wc * 32 + 8 * fq;
        const int r0 = wr * 64 + fr;
#pragma unroll
        for (int ai = 0; ai < 2; ++ai)
#pragma unroll
            for (int m = 0; m < 4; ++m) { bf16* rp = base + (size_t)(r0 + ai * 128 + m * 16) * KCAT;
#pragma unroll
                for (int bj = 0; bj < 2; ++bj) *(v4u*)(rp + bj * 128) = pack8(acc[ai][bj][m][0], acc[ai][bj][m][1]); }
    }
};

struct EpiS {
    static constexpr bool PERM = true;
    const float* l2tab; bf16* acat;
    __device__ __forceinline__ void operator()(const accv (&acc)[2][2][4][2], const Unit& u, int wr, int wc, int fr, int fq) const {
        const int h = u.pn, c = u.pm;
        float l2a = l2tab[h], l2b = l2tab[8 + h];
        const int i0 = wr * 64 + fr, j0 = wc * 32 + 8 * fq;
        bf16* base = acat + ((size_t)h * S_ + (size_t)c * 256) * KCAT + j0;
#pragma unroll
        for (int ai = 0; ai < 2; ++ai)
#pragma unroll
            for (int m = 0; m < 4; ++m) { const int i = i0 + ai * 128 + m * 16;
#pragma unroll
                for (int bj = 0; bj < 2; ++bj) { accv v[2];
#pragma unroll
                    for (int n = 0; n < 2; ++n)
#pragma unroll
                        for (int j = 0; j < 4; ++j) { const float dd = (float)(i - (bj * 128 + j0 + 4 * n + j)); const float e = l2a * fmaxf(dd, 0.f) - l2b * fminf(dd, 0.f); v[n][j] = acc[ai][bj][m][n][j] * fast_exp2(e); }
                    *(v4u*)(base + (size_t)i * KCAT + bj * 128) = pack8(v[0], v[1]); }
                asm volatile("" : "+v"(l2a), "+v"(l2b) :: "memory"); }
    }
};

struct EpiPool {
    static constexpr bool PERM = true;
    const float* pscale; bf16* mix;
    __device__ __forceinline__ void operator()(const accv (&acc)[2][2][4][2], const Unit& u, int wr, int wc, int fr, int fq) const {
        const int row0 = u.pm * 256 + wr * 64 + fr, colp = u.pn * 256 + wc * 32 + 8 * fq;
        accv sc[2][2];
#pragma unroll
        for (int bj = 0; bj < 2; ++bj)
#pragma unroll
            for (int n = 0; n < 2; ++n) sc[bj][n] = *(const accv*)(pscale + colp + bj * 128 + 4 * n);
#pragma unroll
        for (int ai = 0; ai < 2; ++ai)
#pragma unroll
            for (int m = 0; m < 4; ++m) { bf16* rp = mix + (size_t)(row0 + ai * 128 + m * 16) * DM + RD + colp;
#pragma unroll
                for (int bj = 0; bj < 2; ++bj) *(v4u*)(rp + bj * 128) = pack8(acc[ai][bj][m][0] * sc[bj][0], acc[ai][bj][m][1] * sc[bj][1]); }
    }
};

struct EpiOut {
    static constexpr bool PERM = true;
    const float* hnorm; const bf16* gs; bf16* mix; LAS float* scr;
    __device__ __forceinline__ void operator()(const accv (&acc)[2][2][4][2], const Unit& u, int wr, int wc, int fr, int fq) const {
        const int h = u.pn, c = u.pm; const int i0 = wr * 64 + fr, e0 = wc * 32 + 8 * fq;
#pragma unroll
        for (int ai = 0; ai < 2; ++ai)
#pragma unroll
            for (int m = 0; m < 4; ++m) { float ss = 0.f;
#pragma unroll
                for (int bj = 0; bj < 2; ++bj)
#pragma unroll
                    for (int n = 0; n < 2; ++n) { const accv x = acc[ai][bj][m][n]; ss += (x[0] * x[0] + x[1] * x[1]) + (x[2] * x[2] + x[3] * x[3]); }
                ss += __shfl_xor(ss, 16); ss += __shfl_xor(ss, 32);
                if (fq == 0) scr[(i0 + ai * 128 + m * 16) * 4 + wc] = ss; }
        asm volatile("s_waitcnt lgkmcnt(0)" ::: "memory"); __builtin_amdgcn_s_barrier(); asm volatile("" ::: "memory");
        accv hn[2][2];
#pragma unroll
        for (int bj = 0; bj < 2; ++bj)
#pragma unroll
            for (int n = 0; n < 2; ++n) hn[bj][n] = *(const accv*)(hnorm + h * 256 + bj * 128 + e0 + 4 * n);
#pragma unroll
        for (int ai = 0; ai < 2; ++ai)
#pragma unroll
            for (int m = 0; m < 4; ++m) { const int i = i0 + ai * 128 + m * 16; const accv p = *(const LAS accv*)(scr + i * 4);
                const float rn = 1.0f / sqrtf(((p[0] + p[1]) + (p[2] + p[3])) * (1.0f / HD) + EPS);
                const size_t o = (size_t)(c * 256 + i) * RD + h * 256 + e0;
#pragma unroll
                for (int bj = 0; bj < 2; ++bj) { const v4u gv = *(const v4u*)(gs + o + bj * 128);
                    accv g0, g1; g0[0] = bf2f(gv.x & 0xffffu); g0[1] = bf2f(gv.x >> 16); g0[2] = bf2f(gv.y & 0xffffu); g0[3] = bf2f(gv.y >> 16);
                    g1[0] = bf2f(gv.z & 0xffffu); g1[1] = bf2f(gv.z >> 16); g1[2] = bf2f(gv.w & 0xffffu); g1[3] = bf2f(gv.w >> 16);
                    *(v4u*)(mix + (size_t)(c * 256 + i) * DM + h * 256 + bj * 128 + e0) = pack8(acc[ai][bj][m][0] * rn * hn[bj][0] * g0, acc[ai][bj][m][1] * rn * hn[bj][1] * g1); } }
        asm volatile("s_waitcnt lgkmcnt(0)" ::: "memory"); __builtin_amdgcn_s_barrier(); asm volatile("" ::: "memory");
    }
};

struct SchedKV {
    int G, c;
    __device__ __forceinline__ bool next(int i, Unit& u) const { const int L = i * G + c; if (L >= NH * NCH * 2) return false; u.z = L & 1; u.pm = (L >> 1) & (NCH - 1); u.pn = L >> 7; return true; }
    __device__ __forceinline__ size_t a_off(const Unit& u) const { return ((size_t)(u.pn * NCH + u.pm) * 256 * KCAT) * 2; }
    __device__ __forceinline__ size_t b_off(const Unit& u) const { return ((size_t)u.z * RD * S_ + (size_t)u.pn * 256 * S_ + (size_t)u.pm * 256) * 2; }
};
struct SchedS {
    int G, c;
    __device__ __forceinline__ bool next(int i, Unit& u) const { const int L = i * G + c; if (L >= NH * NCH) return false; u.z = 0; u.pm = L & (NCH - 1); u.pn = L >> 6; return true; }
    __device__ __forceinline__ size_t a_off(const Unit& u) const { return ((size_t)u.pm * 256 * RD + (size_t)u.pn * 256) * 2; }
    __device__ __forceinline__ size_t b_off(const Unit& u) const { return a_off(u); }
};
struct SchedPool {
    int G, c;
    __device__ __forceinline__ bool next(int i, Unit& u) const { const int L = i * G + c; if (L >= NCH * 8) return false; u.z = 0; u.pn = L & 7; u.pm = L >> 3; return true; }
    __device__ __forceinline__ size_t a_off(const Unit& u) const { return ((size_t)u.pm * 256 * PD + (size_t)(u.pn >> 1) * 512) * 2; }
    __device__ __forceinline__ size_t b_off(const Unit& u) const { return ((size_t)u.pn * 256 * 512) * 2; }
};
struct SchedOut {
    int G, c;
    __device__ __forceinline__ bool next(int i, Unit& u) const { const int L = i * G + c; if (L >= NH * NCH) return false; u.z = 0; u.pm = L & (NCH - 1); u.pn = L >> 6; return true; }
    __device__ __forceinline__ size_t a_off(const Unit& u) const { return (((size_t)u.pn * S_ + (size_t)u.pm * 256) * KCAT) * 2; }
    __device__ __forceinline__ size_t b_off(const Unit& u) const { return ((size_t)(u.pn * NCH + u.pm) * 256 * KCAT) * 2; }
};

struct Frame {
    LAS unsigned char* lds;
    volatile LAS unsigned* MISC;
    int tid, lane, wave, G;
};

__device__ __forceinline__ float wave_sum(float v) {
#pragma unroll
    for (int o = 1; o < 64; o <<= 1) v += __shfl_xor(v, o);
    return v;
}

__device__ __forceinline__ void tr_matrix(Frame& F, const float* __restrict__ W, int K, int N, const float* __restrict__ gain, bf16* WT, int blk, int dblk, int doff, int gwi, int ngw) {
    LAS float* scr = (LAS float*)(F.lds + F.wave * TR_BYTES);
    const int nblk = N / 64, nitems = (K / 64) * nblk, lane = F.lane;
    const int lr = lane >> 4, lc = (lane & 15) * 4;
    int it = gwi; if (it >= nitems) return;
    f32x4 v[16]; float gs[16];
    int k0 = 64 * (it / nblk), n0 = 64 * (it % nblk);
#pragma unroll
    for (int i = 0; i < 16; ++i) { v[i] = *(const f32x4*)(W + (size_t)(k0 + lr + 4 * i) * N + n0 + lc); gs[i] = gain ? gain[k0 + lr + 4 * i] : 1.0f; }
    for (;;) {
#pragma unroll
        for (int i = 0; i < 16; ++i) { LAS float* d = scr + (lr + 4 * i) * TR_LD + lc; d[0] = v[i][0] * gs[i]; d[1] = v[i][1] * gs[i]; d[2] = v[i][2] * gs[i]; d[3] = v[i][3] * gs[i]; }
        const int ck0 = k0, cn0 = n0; const int itn = it + ngw; const bool more = itn < nitems;
        if (more) { k0 = 64 * (itn / nblk); n0 = 64 * (itn % nblk);
#pragma unroll
            for (int i = 0; i < 16; ++i) { v[i] = *(const f32x4*)(W + (size_t)(k0 + lr + 4 * i) * N + n0 + lc); gs[i] = gain ? gain[k0 + lr + 4 * i] : 1.0f; } }
        LDS_WAIT(); asm volatile("" ::: "memory");
        const int cc = lane & 7;
        const int drow0 = (cn0 / blk) * dblk + doff + (cn0 % blk);
#pragma unroll
        for (int j = 0; j < 8; ++j) { const int n = (lane >> 3) + 8 * j; const LAS float* sp = scr + (8 * cc) * TR_LD + n;
            float t[8];
#pragma unroll
            for (int q = 0; q < 8; ++q) t[q] = sp[q * TR_LD];
            v4u o; o.x = pk2t(t[0], t[1]); o.y = pk2t(t[2], t[3]); o.z = pk2t(t[4], t[5]); o.w = pk2t(t[6], t[7]);
            *(v4u*)(WT + (size_t)(drow0 + n) * K + ck0 + 8 * cc) = o; }
        LDS_WAIT(); asm volatile("" ::: "memory");
        if (!more) break;
        it = itn;
    }
}

template <int W> __device__ __forceinline__ void pooled_block(const bf16* __restrict__ pbuf, bf16* __restrict__ pooled, int s0, int cv) {
    constexpr int RB = 8, LO = W / 2, HI = W - 1 - LO, NR = RB + W - 1;
    v4u raw[NR];
#pragma unroll
    for (int q = 0; q < NR; ++q) { const int r = s0 - LO + q; const int rc = r < 0 ? 0 : (r >= S_ ? S_ - 1 : r); raw[q] = *(const v4u*)(pbuf + (size_t)rc * PD + cv * 8); }
#pragma unroll
    for (int q = 0; q < NR; ++q) { const int r = s0 - LO + q; if (r < 0 || r >= S_) raw[q] = (v4u){0u, 0u, 0u, 0u}; }
    accv ra = {0.f, 0.f, 0.f, 0.f}, rb = {0.f, 0.f, 0.f, 0.f};
#pragma unroll
    for (int q = 0; q < W; ++q) { accv a, b; unpack8(raw[q], a, b); ra += a; rb += b; }
#pragma unroll
    for (int i = 0; i < RB; ++i) { const int s = s0 + i; int st = s - LO; st = st < 0 ? 0 : st; int en = s + HI + 1; en = en > S_ ? S_ : en; const float inv = 1.0f / (float)(en - st);
        accv sa, sb; unpack8(raw[i + LO], sa, sb);
        *(v4u*)(pooled + (size_t)s * PD + cv * 8) = pack8(ra * inv - sa, rb * inv - sb);
        if (i < RB - 1) { accv a, b, c, d; unpack8(raw[i + W], a, b); unpack8(raw[i], c, d); ra += a - c; rb += b - d; } }
}
struct Args { const float* in[19]; const int* pos; float* out; unsigned char* ws; int ph_lo, ph_hi; };
static_assert(sizeof(Args) == 19 * 8 + 8 + 8 + 8 + 8, "Args has no padding");

enum { IN_X = 0, IN_POS = 1, IN_F1N = 2, IN_F1G = 3, IN_F1U = 4, IN_F1D = 5, IN_MIXN = 6, IN_WIN = 7, IN_DECF = 8, IN_DECB = 9, IN_HNORM = 10, IN_POOLW = 11, IN_PSCALE = 12,
       IN_WOUT = 13, IN_F2N = 14, IN_F2G = 15, IN_F2U = 16, IN_F2D = 17, IN_FINN = 18 };
constexpr int NPHASE = 11;
#ifndef MK_DUP
#define MK_DUP (-1)
#endif
#ifndef MK_SUB
#define MK_SUB 0
#endif
#define SUBON(k) (!rep || MK_SUB == 0 || MK_SUB == (k))
#ifndef MK_PHASE_MASK
#define MK_PHASE_MASK 0x7ff
#endif

typedef const __attribute__((address_space(4))) Args* KArgs;
__device__ __forceinline__ KArgs kargs() { KArgs p = (KArgs)__builtin_amdgcn_kernarg_segment_ptr(); asm volatile("" : "+s"(p)); return p; }
#define GP(T, p) ((T*)(GAS T*)(p))
__device__ __forceinline__ void grid_sync(Frame& F) {
    KArgs ap = kargs(); XcdBarrier b; b.bar = (unsigned*)(GP(unsigned char, ap->ws) + WS_CTL) + CW_BAR; b.x = xb_xcc_id(); b.st = F.MISC + 8; xcd_barrier(b);
}

__global__ void __launch_bounds__(NWAVES * 64, 2) fwd_kernel(Args args) {
    extern __shared__ __attribute__((aligned(16))) unsigned char lds[];
    Frame F;
    F.lds = (LAS unsigned char*)lds;
    F.MISC = (volatile LAS unsigned*)(F.lds + MISC_OFF);
    F.tid = threadIdx.x; F.lane = F.tid & 63; F.wave = __builtin_amdgcn_readfirstlane(F.tid >> 6);
    F.G = gridDim.x;
    if (F.tid < 64) F.MISC[F.tid] = 0u;
    __syncthreads();
    { KArgs ap = kargs(); (void)xcd_barrier_post((unsigned*)(GP(unsigned char, ap->ws) + WS_CTL) + CW_BAR, F.MISC + 8); }
    const int lo = args.ph_lo, hi = args.ph_hi;
#define IN(k) (lo <= (k) && (k) < hi)
#define PHON(k) (((MK_PHASE_MASK) >> (k)) & 1)
#define SEAM(k) do { if (IN(k) && IN((k) + 1)) grid_sync(F); } while (0)
#if MK_DUP == 0
#define RL0 for (int rep = 0; rep < 2; ++rep)
#else
#define RL0 if (const int rep = 0; true)
#endif
#if MK_DUP == 1
#define RL1 for (int rep = 0; rep < 2; ++rep)
#else
#define RL1 if (const int rep = 0; true)
#endif
#if MK_DUP == 2
#define RL2 for (int rep = 0; rep < 2; ++rep)
#else
#define RL2 if (const int rep = 0; true)
#endif
#if MK_DUP == 3
#define RL3 for (int rep = 0; rep < 2; ++rep)
#else
#define RL3 if (const int rep = 0; true)
#endif
#if MK_DUP == 4
#define RL4 for (int rep = 0; rep < 2; ++rep)
#else
#define RL4 if (const int rep = 0; true)
#endif
#if MK_DUP == 5
#define RL5 for (int rep = 0; rep < 2; ++rep)
#else
#define RL5 if (const int rep = 0; true)
#endif
#if MK_DUP == 6
#define RL6 for (int rep = 0; rep < 2; ++rep)
#else
#define RL6 if (const int rep = 0; true)
#endif
#if MK_DUP == 7
#define RL7 for (int rep = 0; rep < 2; ++rep)
#else
#define RL7 if (const int rep = 0; true)
#endif
#if MK_DUP == 8
#define RL8 for (int rep = 0; rep < 2; ++rep)
#else
#define RL8 if (const int rep = 0; true)
#endif
#if MK_DUP == 9
#define RL9 for (int rep = 0; rep < 2; ++rep)
#else
#define RL9 if (const int rep = 0; true)
#endif
#if MK_DUP == 10
#define RL10 for (int rep = 0; rep < 2; ++rep)
#else
#define RL10 if (const int rep = 0; true)
#endif
#define PHASE(k) if (PHON(k) && IN(k)) RL##k
#define PHASE_ENV KArgs ap = kargs(); unsigned char* ws = GP(unsigned char, ap->ws); float* rsq = (float*)(ws + WS_CTL) + CW_RSQ; float* xres = GP(float, ap->out); bf16* xb = (bf16*)(ws + WS_XB); \
    float* const dum_rs = (float*)(ws + WS_TAB + 65536); (void)rsq; (void)xres; (void)xb; (void)dum_rs; if (rep) grid_sync(F)
#define AIN(k) GP(const float, ap->in[k])
    const int gw = blockIdx.x * NWAVES + F.wave, NGW = F.G * NWAVES;
    const int gt = blockIdx.x * (NWAVES * 64) + F.tid, NGT = F.G * NWAVES * 64;

    PHASE(0) { PHASE_ENV;
        tr_matrix(F, AIN(IN_F1G), DM, FF, AIN(IN_F1N), (bf16*)(ws + WS_WGU1), 128, 256, 0, gw, NGW);
        tr_matrix(F, AIN(IN_F1U), DM, FF, AIN(IN_F1N), (bf16*)(ws + WS_WGU1), 128, 256, 128, gw, NGW);
        tr_matrix(F, AIN(IN_F1D), FF, DM, nullptr, (bf16*)(ws + WS_WD1), DM, 0, 0, gw, NGW);
        tr_matrix(F, AIN(IN_F2G), DM, FF, AIN(IN_F2N), (bf16*)(ws + WS_WGU2), 128, 256, 0, gw, NGW);
        tr_matrix(F, AIN(IN_F2U), DM, FF, AIN(IN_F2N), (bf16*)(ws + WS_WGU2), 128, 256, 128, gw, NGW);
        tr_matrix(F, AIN(IN_F2D), FF, DM, nullptr, (bf16*)(ws + WS_WD2), DM, 0, 0, gw, NGW);
#pragma unroll 1
        for (int g = 0; g < 4; ++g) tr_matrix(F, AIN(IN_POOLW) + (size_t)g * 512 * 512, 512, 512, nullptr, (bf16*)(ws + WS_WPOOL) + (size_t)g * 512 * 512, 512, 0, 0, gw, NGW);
        const float* x = AIN(IN_X);
        for (int m = gw; m < S_; m += NGW) {
            const f32x4* xr = (const f32x4*)(x + (size_t)m * DM) + F.lane; float ss = 0.f;
            f32x4 xv[16];
#pragma unroll
            for (int j = 0; j < 16; ++j) xv[j] = xr[64 * j];
            asm volatile("" ::: "memory");
#pragma unroll
            for (int j = 0; j < 16; ++j) { const f32x4 a = xv[j];
                ss += (a[0] * a[0] + a[1] * a[1]) + (a[2] * a[2] + a[3] * a[3]);
                v2u pa; pa.x = pk2(a[0], a[1]); pa.y = pk2(a[2], a[3]);
                *((v2u*)(xb + (size_t)m * DM) + F.lane + 64 * j) = pa; }
            ss = wave_sum(ss);
            if (F.lane == 0) rsq[m] = ss;
        }
        if (gt < 16) ((float*)(ws + WS_TAB))[gt] = log2_sigmoid((gt < 8 ? AIN(IN_DECF) : AIN(IN_DECB))[gt & 7]);
        float* cst = (float*)(ws + WS_CS); const int* pos = GP(const int, ap->pos);
        for (int t = gt; t < S_ * 128; t += NGT) { const int s = t >> 7, i = t & 127;
            const float pw = (float)pow(10000.0, (double)((float)i * (1.0f / 128.0f))); const float fr = 1.0f / pw;
            const float ang = (float)pos[s] * fr;
            const double rev = (double)ang * 0.15915494309189533577; const float fr_rev = (float)(rev - rint(rev));
            cst[t] = __builtin_amdgcn_cosf(fr_rev); cst[(size_t)S_ * 128 + t] = __builtin_amdgcn_sinf(fr_rev); }
    }
    SEAM(0);

    PHASE(1) { PHASE_ENV;
        pg8::Gemm g{xb, (const bf16*)(ws + WS_WGU1), DM, DM, DM}; pg8::SchedGrid S; S.init(S_ / 256, 2 * FF / 256, F.G, (int)blockIdx.x, DM, DM);
        EpiGateUp E{rsq, (bf16*)(ws + WS_ACT)};
        pg8::gemm_phase(F.lds + RING_OFF, g, S, E);
        if (!rep) {
            const int nun = (S_ / 256) * (2 * FF / 256), rem = nun % F.G, first = rem, nidle = F.G - first;
            if ((int)blockIdx.x >= first) { const int gwi = ((int)blockIdx.x - first) * NWAVES + F.wave, ngw = nidle * NWAVES;
                tr_matrix(F, AIN(IN_WIN), DM, PROJ, AIN(IN_MIXN), (bf16*)(ws + WS_WIN), PROJ, 0, 0, gwi, ngw);
                tr_matrix(F, AIN(IN_WOUT), DM, DM, nullptr, (bf16*)(ws + WS_WOUT), DM, 0, 0, gwi, ngw); }
        }
    }
    SEAM(1);
    PHASE(2) { PHASE_ENV;
        pg8::Gemm g{(const bf16*)(ws + WS_ACT), (const bf16*)(ws + WS_WD1), FF, FF, FF}; pg8::SchedGrid S; S.init(S_ / 256, DM / 256, F.G, (int)blockIdx.x, FF, FF, 2);
        EpiResid E{rep ? (bf16*)(ws + WS_ACAT) : xb, rep ? dum_rs : rsq + S_, 0.5f};
        pg8::gemm_phase(F.lds + RING_OFF, g, S, E);
    }
    SEAM(2);
    PHASE(3) { PHASE_ENV;
        pg8::Gemm g{xb, (const bf16*)(ws + WS_WIN), DM, DM, DM}; pg8::SchedGrid S; S.init(S_ / 256, PROJ / 256, F.G, (int)blockIdx.x, DM, DM);
        EpiZ E{rsq + S_, (const float*)(ws + WS_CS), (const float*)(ws + WS_TAB), (bf16*)(ws + WS_QROW), (bf16*)(ws + WS_KROW), (bf16*)(ws + WS_KDT), (bf16*)(ws + WS_GS), (bf16*)(ws + WS_PB),
               (bf16*)(ws + WS_ACAT), (bf16*)(ws + WS_BCAT)};
        pg8::gemm_phase(F.lds + RING_OFF, g, S, E);
    }
    SEAM(3);
    PHASE(4) { PHASE_ENV;
        if (SUBON(1)) {   const bf16* pbuf = (const bf16*)(ws + WS_PB); bf16* pooled = (bf16*)(ws + WS_POOLED);
            for (int t = gt; t < (S_ / 8) * (PD / 8); t += NGT) { const int s0 = (t >> 8) * 8, cv = t & 255, grp = cv >> 6;
                if (grp == 0) pooled_block<2>(pbuf, pooled, s0, cv); else if (grp == 1) pooled_block<4>(pbuf, pooled, s0, cv);
                else if (grp == 2) pooled_block<8>(pbuf, pooled, s0, cv); else pooled_block<16>(pbuf, pooled, s0, cv); }
            VM_WAIT(); __syncthreads();
        }
        if (SUBON(2)) {   pg8::Gemm g{(const bf16*)(ws + WS_BCAT), (const bf16*)(ws + WS_KDT), KCAT, S_, CH}; SchedKV S{F.G, (int)blockIdx.x};
            EpiKV E{(bf16*)(ws + WS_BCAT)};
            pg8::gemm_phase(F.lds + RING_OFF, g, S, E); }
        if (SUBON(3)) {   pg8::Gemm g{(const bf16*)(ws + WS_QROW), (const bf16*)(ws + WS_KROW), RD, RD, HD}; SchedS S{F.G, (int)blockIdx.x};
            EpiS E{(const float*)(ws + WS_TAB), (bf16*)(ws + WS_ACAT)};
            pg8::gemm_phase(F.lds + RING_OFF, g, S, E); }
    }
    SEAM(4);
    PHASE(5) { PHASE_ENV;
        if (!rep) {   bf16* bcat = (bf16*)(ws + WS_BCAT);
            for (int t = gt; t < 2 * NH * HD * (HD / 8); t += NGT) { const int dir = t >> 16, rem = t & 65535, h = rem >> 13, e = (rem >> 5) & 255, dv = rem & 31;
                const float l2 = ((const float*)(ws + WS_TAB))[dir * 8 + h]; const float dC = fast_exp2(l2 * (float)CH);
                bf16* p0 = bcat + ((size_t)(h * NCH) * 256 + e) * KCAT + 256 + 256 * dir + dv * 8; const size_t cstep = (size_t)256 * KCAT;
                float run[8];
#pragma unroll
                for (int j = 0; j < 8; ++j) run[j] = 0.f;
#pragma unroll 1
                for (int cb = 0; cb < NCH; cb += 8) { v4u kv[8];
#pragma unroll
                    for (int q = 0; q < 8; ++q) { const int c = dir ? (NCH - 1 - (cb + q)) : (cb + q); kv[q] = *(const v4u*)(p0 + (size_t)c * cstep); }
#pragma unroll
                    for (int q = 0; q < 8; ++q) { const int c = dir ? (NCH - 1 - (cb + q)) : (cb + q);
                        v4u o; o.x = pk2(run[0], run[1]); o.y = pk2(run[2], run[3]); o.z = pk2(run[4], run[5]); o.w = pk2(run[6], run[7]);
                        *(v4u*)(p0 + (size_t)c * cstep) = o;
                        run[0] = run[0] * dC + bf2f(kv[q].x & 0xffffu); run[1] = run[1] * dC + bf2f(kv[q].x >> 16); run[2] = run[2] * dC + bf2f(kv[q].y & 0xffffu); run[3] = run[3] * dC + bf2f(kv[q].y >> 16);
                        run[4] = run[4] * dC + bf2f(kv[q].z & 0xffffu); run[5] = run[5] * dC + bf2f(kv[q].z >> 16); run[6] = run[6] * dC + bf2f(kv[q].w & 0xffffu); run[7] = run[7] * dC + bf2f(kv[q].w >> 16); } } }
            VM_WAIT(); __syncthreads();
        }
        {   pg8::Gemm g{(const bf16*)(ws + WS_POOLED), (const bf16*)(ws + WS_WPOOL), PD, 512, 512}; SchedPool S{F.G, (int)blockIdx.x};
            EpiPool E{AIN(IN_PSCALE), (bf16*)(ws + WS_MIX)};
            pg8::gemm_phase(F.lds + RING_OFF, g, S, E); }
    }
    SEAM(5);
    PHASE(6) { PHASE_ENV;
        pg8::Gemm g{(const bf16*)(ws + WS_ACAT), (const bf16*)(ws + WS_BCAT), KCAT, KCAT, KCAT}; SchedOut S{F.G, (int)blockIdx.x};
        EpiOut E{AIN(IN_HNORM), (const bf16*)(ws + WS_GS), (bf16*)(ws + WS_MIX), (LAS float*)(F.lds + EPI_SCR_OFF)};
        pg8::gemm_phase(F.lds + RING_OFF, g, S, E);
    }
    SEAM(6);
    PHASE(7) { PHASE_ENV;
        pg8::Gemm g{(const bf16*)(ws + WS_MIX), (const bf16*)(ws + WS_WOUT), DM, DM, DM}; pg8::SchedGrid S; S.init(S_ / 256, DM / 256, F.G, (int)blockIdx.x, DM, DM);
        EpiResid E{rep ? (bf16*)(ws + WS_ACAT) : xb, rep ? dum_rs : rsq + 2 * S_, 1.0f};
        pg8::gemm_phase(F.lds + RING_OFF, g, S, E);
    }
    SEAM(7);
    PHASE(8) { PHASE_ENV;
        pg8::Gemm g{xb, (const bf16*)(ws + WS_WGU2), DM, DM, DM}; pg8::SchedGrid S; S.init(S_ / 256, 2 * FF / 256, F.G, (int)blockIdx.x, DM, DM);
        EpiGateUp E{rsq + 2 * S_, (bf16*)(ws + WS_ACT)};
        pg8::gemm_phase(F.lds + RING_OFF, g, S, E);
    }
    SEAM(8);
    PHASE(9) { PHASE_ENV;
        pg8::Gemm g{(const bf16*)(ws + WS_ACT), (const bf16*)(ws + WS_WD2), FF, FF, FF}; pg8::SchedGrid S; S.init(S_ / 256, DM / 256, F.G, (int)blockIdx.x, FF, FF, 2);
        EpiResid E{rep ? (bf16*)(ws + WS_WGU1) : xb, rep ? dum_rs : rsq + 3 * S_, 0.5f};
        pg8::gemm_phase(F.lds + RING_OFF, g, S, E);
    }
    SEAM(9);
    PHASE(10) { PHASE_ENV;
        const float* fn = AIN(IN_FINN);
        const unsigned tmo = __hip_atomic_load((unsigned*)(ws + WS_CTL) + CW_BAR + XB_TMO, RLX_AGENT);
        for (int m = gw; m < S_; m += NGW) { float rs = 1.0f / sqrtf(rsq[3 * S_ + m] * (1.0f / DM) + EPS);
            if (tmo) rs = __builtin_nanf("");
            const v4u* xr = (const v4u*)(xb + (size_t)m * DM) + F.lane; f32x4* orow = (f32x4*)(xres + (size_t)m * DM);
            v4u xw[8];
#pragma unroll
            for (int j = 0; j < 8; ++j) xw[j] = xr[64 * j];
            asm volatile("" ::: "memory");
#pragma unroll
            for (int j = 0; j < 8; ++j) { accv a, b; unpack8(xw[j], a, b);
                const f32x4 g0 = *((const f32x4*)fn + 2 * (F.lane + 64 * j)), g1 = *((const f32x4*)fn + 2 * (F.lane + 64 * j) + 1);
                orow[2 * (F.lane + 64 * j)] = a * rs * g0; orow[2 * (F.lane + 64 * j) + 1] = b * rs * g1; } }
    }
#undef IN
#undef SEAM
}

#ifndef MK_N_LAUNCHES
#define MK_N_LAUNCHES 1
#endif
extern "C" void kernel_launch(void* const* d_in, const int* in_sizes, int n_in, void* d_out, int out_size, void* d_ws, size_t ws_size, hipStream_t stream) {
    static int grid = 0;
    if (grid == 0) {
        if (n_in != 19 || in_sizes[0] != S_ * DM || out_size != S_ * DM || ws_size < WS_END2) { fprintf(stderr, "kernel_launch: unexpected shapes (n_in %d, in0 %d, out %d, ws %zu); nothing launched\n", n_in, n_in > 0 ? in_sizes[0] : -1, out_size, ws_size); grid = -1; return; }
        int dev = 0, cus = 0, per_cu = 0;
        if (hipGetDevice(&dev) != hipSuccess || hipDeviceGetAttribute(&cus, hipDeviceAttributeMultiprocessorCount, dev) != hipSuccess) { fprintf(stderr, "kernel_launch: device query failed\n"); grid = -1; return; }
        if (hipFuncSetAttribute((const void*)fwd_kernel, hipFuncAttributeMaxDynamicSharedMemorySize, LDS_BYTES) != hipSuccess) { fprintf(stderr, "kernel_launch: hipFuncSetAttribute failed\n"); grid = -1; return; }
        if (hipOccupancyMaxActiveBlocksPerMultiprocessor(&per_cu, (const void*)fwd_kernel, NWAVES * 64, LDS_BYTES) != hipSuccess || per_cu < 1) { fprintf(stderr, "kernel_launch: occupancy query reports %d workgroups per CU\n", per_cu); per_cu = 1; }
        (void)hipGetLastError();
        grid = cus;
    }
    if (grid < 0) return;
    if (hipMemsetAsync((char*)d_ws + WS_CTL, 0, CTL_ZERO_BYTES, stream) != hipSuccess) { fprintf(stderr, "kernel_launch: memset failed\n"); return; }
    Args a{};
    for (int i = 0; i < 19; ++i) a.in[i] = (const float*)d_in[i];
    a.pos = (const int*)d_in[IN_POS]; a.out = (float*)d_out; a.ws = (unsigned char*)d_ws;
#if MK_N_LAUNCHES == 1
    a.ph_lo = 0; a.ph_hi = NPHASE;
    hipLaunchKernelGGL(fwd_kernel, dim3(grid), dim3(NWAVES * 64), LDS_BYTES, stream, a);
#else
    for (int p = 0; p < NPHASE; ++p) { a.ph_lo = p; a.ph_hi = p + 1; hipLaunchKernelGGL(fwd_kernel, dim3(grid), dim3(NWAVES * 64), LDS_BYTES, stream, a); }
#endif
    const hipError_t le = hipPeekAtLastError();
    if (le != hipSuccess) fprintf(stderr, "kernel_launch: launch failed: %s\n", hipGetErrorName(le));
}
```

```cpp
#include <hip/hip_runtime.h>
#include <cstdio>
#include <cstdint>

namespace pg8 {
#define PG8_LAS __attribute__((address_space(3)))
typedef unsigned short bf16_t;
typedef short bf16x8 __attribute__((ext_vector_type(8)));
typedef float f32x4 __attribute__((ext_vector_type(4)));
typedef unsigned u32x4 __attribute__((ext_vector_type(4)));
constexpr int BM = 256, BK = 64, HALF = 128, HTB = HALF * BK * 2  , STAGE_BYTES = 8 * HTB, NXCD = 8, WGM = 8;

__host__ __device__ __forceinline__ int lds_byte(int r, int c) { const int st = (r >> 4) * 2 + (c >> 5), rr = r & 15, cc = c & 31, ob = rr * 64 + cc * 2; return st * 1024 + (ob ^ (((ob >> 9) & 1) << 5)); }
__host__ __device__ __forceinline__ void stage_rc(int b, int& R, int& C) { const int st = b / 1024, sb = b % 1024, swz = sb ^ (((sb >> 9) & 1) << 5); R = (st >> 1) * 16 + swz / 64; C = (st & 1) * 32 + (swz % 64) / 2; }
__host__ __device__ __forceinline__ int perm32(int rho) { const int n = rho >> 4, i = rho & 15; return 8 * (i >> 2) + 4 * n + (i & 3); }

struct Unit { int pm, pn, z; };
struct Gemm { const bf16_t* A; const bf16_t* Bt; int lda, ldb, K; const bf16_t* A2; };

struct SchedGrid {
    int nM, nN, nwg, G, c, wgm; size_t astep, bstep;
    __device__ __forceinline__ void init(int nM_, int nN_, int G_, int c_, int lda, int ldb, int wgm_ = WGM) { nM = nM_; nN = nN_; nwg = nM * nN; G = G_; c = c_; wgm = wgm_; astep = (size_t)BM * lda * 2; bstep = (size_t)BM * ldb * 2; }
    __device__ __forceinline__ bool next(int i, Unit& u) const {
        const long L = (long)i * G + c; if (L >= nwg) return false;
        int wgid = (int)L; { const int q = nwg / NXCD, r = nwg % NXCD, xcd = wgid % NXCD, off = wgid / NXCD; wgid = (xcd < r ? xcd * (q + 1) : r * (q + 1) + (xcd - r) * q) + off; }
        const int nig = wgm * nN, gid = wgid / nig, fm = gid * wgm, gsz = (nM - fm) < wgm ? (nM - fm) : wgm;
        u.pm = fm + ((wgid % nig) % gsz); u.pn = (wgid % nig) / gsz; u.z = 0; return true;
    }
    __device__ __forceinline__ size_t a_off(const Unit& u) const { return (size_t)u.pm * astep; }
    __device__ __forceinline__ size_t b_off(const Unit& u) const { return (size_t)u.pn * bstep; }
};

__device__ __forceinline__ unsigned cvt_pk_bf16(float lo, float hi) { unsigned r; asm volatile("v_cvt_pk_bf16_f32 %0, %1, %2" : "=v"(r) : "v"(lo), "v"(hi)); return r; }

template <class Epi, class Sched, bool SEG3 = false>
__device__ __forceinline__ void gemm_phase(PG8_LAS unsigned char* lds, const Gemm g, const Sched& S, const Epi& E) {
    const int tid = threadIdx.x, wid = __builtin_amdgcn_readfirstlane(tid >> 6), lane = tid & 63, wr = wid >> 2, wc = wid & 3, fr = lane & 15, fq = lane >> 4;
    int nt = g.K / BK; asm volatile("" : "+s"(nt));
    unsigned voffA[2], voffB[2];
#pragma unroll
    for (int i = 0; i < 2; ++i) { int R, C; stage_rc(tid * 16 + i * 8192, R, C); const int Rb = (R & ~31) + perm32(R & 31);
        voffA[i] = (unsigned)(R * g.lda + C) * 2u; voffB[i] = (unsigned)(Rb * g.ldb + C) * 2u; }
    const size_t kstep = (size_t)(BK * 2);
    const size_t hstepA = (size_t)HALF * g.lda * 2, hstepB = (size_t)HALF * g.ldb * 2;
    const unsigned ldsw = (unsigned)wid * 1024u;
    const int aoff = lds_byte(wr * 64 + fr, fq * 8), boff = lds_byte(wc * 32 + fr, fq * 8);
#define PG8_SA(b, h) (((b) * 2 + (h)) * HTB)
#define PG8_SB(b, h) ((4 + (b) * 2 + (h)) * HTB)
#define PG8_STAGE(bufoff, gbase, voff) do { _Pragma("unroll") for (int _i = 0; _i < 2; ++_i) \
        __builtin_amdgcn_global_load_lds((const unsigned*)((const char*)(gbase) + (voff)[_i]), (PG8_LAS unsigned*)(lds + (bufoff) + ldsw + _i * 8192), 16, 0, 0); } while (0)
#define PG8_LDA(dst, b, h) do { _Pragma("unroll") for (int m = 0; m < 4; ++m) _Pragma("unroll") for (int k = 0; k < 2; ++k) dst[m][k] = *(const PG8_LAS bf16x8*)(lds + PG8_SA(b, h) + aoff + m * 2048 + k * 1024); } while (0)
#define PG8_LDB(dst, b, h) do { _Pragma("unroll") for (int n = 0; n < 2; ++n) _Pragma("unroll") for (int k = 0; k < 2; ++k) dst[n][k] = *(const PG8_LAS bf16x8*)(lds + PG8_SB(b, h) + boff + n * 2048 + k * 1024); } while (0)
#define PG8_MMA(ai, bj, At, Bt) do { __builtin_amdgcn_s_setprio(1); _Pragma("unroll") for (int m = 0; m < 4; ++m) _Pragma("unroll") for (int n = 0; n < 2; ++n) _Pragma("unroll") for (int k = 0; k < 2; ++k) \
        acc[ai][bj][m][n] = __builtin_amdgcn_mfma_f32_16x16x32_bf16(Bt[n][k], At[m][k], acc[ai][bj][m][n], 0, 0, 0); __builtin_amdgcn_s_setprio(0); } while (0)
#define PG8_WAIT_V(n) asm volatile("s_waitcnt vmcnt(" #n ")" ::: "memory")
#define PG8_WAIT_L(n) asm volatile("s_waitcnt lgkmcnt(" #n ")" ::: "memory")
#define PG8_BAR __builtin_amdgcn_s_barrier()
#define PG8_SCHED __builtin_amdgcn_sched_barrier(0)
    Unit cur, nxt; int ui = 0;
    if (!S.next(0, cur)) return;
    f32x4 acc[2][2][4][2];
#pragma unroll
    for (int a = 0; a < 2; ++a)
#pragma unroll
        for (int b = 0; b < 2; ++b)
#pragma unroll
            for (int m = 0; m < 4; ++m)
#pragma unroll
                for (int n = 0; n < 2; ++n) acc[a][b][m][n] = (f32x4){0.f, 0.f, 0.f, 0.f};
    bf16x8 At[4][2], B0[2][2], B1[2][2];
    const char* cA = (const char*)g.A + S.a_off(cur); const char* cB = (const char*)g.Bt + S.b_off(cur);
    const char* cA2 = SEG3 ? (const char*)g.A2 + S.a_off(cur) : nullptr;
#define PG8_ATILE(t_) (SEG3 ? (((t_) < 8) ? cA + (size_t)((t_) & 3) * kstep : cA2 + (size_t)((t_) - 8) * kstep) : cA + (size_t)(t_) * kstep)
    PG8_STAGE(PG8_SB(0, 0), cB, voffB); PG8_STAGE(PG8_SB(0, 1), cB + hstepB, voffB); PG8_STAGE(PG8_SA(0, 0), cA, voffA); PG8_STAGE(PG8_SA(0, 1), cA + hstepA, voffA);
    if (wr == 1) PG8_BAR;
    PG8_WAIT_V(2); PG8_BAR;
    PG8_STAGE(PG8_SB(1, 0), cB + kstep, voffB); PG8_STAGE(PG8_SA(1, 0), cA + kstep, voffA); PG8_STAGE(PG8_SB(1, 1), cB + hstepB + kstep, voffB);
    PG8_WAIT_V(6); PG8_BAR;
    for (;;) {
        const bool has_next = S.next(ui + 1, nxt);
        const char* nA = has_next ? (const char*)g.A + S.a_off(nxt) : cA; const char* nB = has_next ? (const char*)g.Bt + S.b_off(nxt) : cB;
        for (int t = 0; t < nt; t += 2) {
            const bool last = (t == nt - 2);
            const char* a1 = PG8_ATILE(t + 1);
            const char* a2 = last ? nA : PG8_ATILE(t + 2); const char* b2 = last ? nB : cB + (size_t)(t + 2) * kstep;
            const char* a3 = a2 + kstep; const char* b3 = b2 + kstep;
            if constexpr (SEG3) { if (t == 4 || t == 8) E.seg_scale(acc, cur, t, wr, fr); }
            PG8_LDB(B0, 0, 0); PG8_LDB(B1, 0, 1); PG8_SCHED; PG8_LDA(At, 0, 0); PG8_STAGE(PG8_SA(1, 1), a1 + hstepA, voffA);
            PG8_WAIT_V(8); PG8_WAIT_L(0); PG8_BAR; PG8_MMA(0, 0, At, B0); PG8_MMA(0, 1, At, B1); PG8_BAR; PG8_SCHED;
            PG8_LDA(At, 0, 1); PG8_STAGE(PG8_SB(0, 0), b2, voffB); PG8_STAGE(PG8_SB(0, 1), b2 + hstepB, voffB); PG8_STAGE(PG8_SA(0, 0), a2, voffA);
            PG8_WAIT_V(8); PG8_WAIT_L(0); PG8_BAR; PG8_MMA(1, 0, At, B0); PG8_MMA(1, 1, At, B1); PG8_BAR; PG8_SCHED;
            PG8_LDB(B0, 1, 0); PG8_LDB(B1, 1, 1); PG8_SCHED; PG8_LDA(At, 1, 0); PG8_STAGE(PG8_SA(0, 1), a2 + hstepA, voffA);
            PG8_WAIT_V(8); PG8_WAIT_L(0); PG8_BAR; PG8_MMA(0, 0, At, B0); PG8_MMA(0, 1, At, B1); PG8_BAR; PG8_SCHED;
            PG8_LDA(At, 1, 1); PG8_STAGE(PG8_SB(1, 0), b3, voffB); PG8_STAGE(PG8_SB(1, 1), b3 + hstepB, voffB); PG8_STAGE(PG8_SA(1, 0), a3, voffA);
            PG8_WAIT_V(8); PG8_WAIT_L(0); PG8_BAR; PG8_MMA(1, 0, At, B0); PG8_MMA(1, 1, At, B1); PG8_BAR; PG8_SCHED;
        }
        if (wr == 0) PG8_BAR;
        { int fr2 = fr, fq2 = fq; asm volatile("" : "+v"(fr2), "+v"(fq2));
          E(acc, cur, wr, wc, fr2, fq2); }
        if (!has_next) break;
#pragma unroll
        for (int a = 0; a < 2; ++a)
#pragma unroll
            for (int b = 0; b < 2; ++b)
#pragma unroll
                for (int m = 0; m < 4; ++m)
#pragma unroll
                    for (int n = 0; n < 2; ++n) acc[a][b][m][n] = (f32x4){0.f, 0.f, 0.f, 0.f};
        cur = nxt; cA = nA; cB = nB; ++ui; if constexpr (SEG3) cA2 = (const char*)g.A2 + S.a_off(cur);
        if (wr == 1) PG8_BAR;
    }
    PG8_WAIT_V(0);
    PG8_BAR;
#undef PG8_ATILE
#undef PG8_SA
#undef PG8_SB
#undef PG8_STAGE
#undef PG8_LDA
#undef PG8_LDB
#undef PG8_MMA
#undef PG8_WAIT_V
#undef PG8_WAIT_L
#undef PG8_BAR
#undef PG8_SCHED
}
}

constexpr int NWAVES = 8;
constexpr int S_ = 16384, DM = 4096, FF = 11008, PROJ = 10240, RD = 2048, NH = 8, HD = 256, CH = 256, NCH = S_ / CH, PD = 2048;
constexpr float EPS = 1e-6f;
constexpr int KCAT = 768;

constexpr size_t MiB = 1u << 20;
constexpr size_t WS_CTL = 0, CTL_ZERO_BYTES = 1 * MiB;
constexpr size_t WS_TAB = 1 * MiB;
constexpr size_t WS_CS = 2 * MiB;
constexpr size_t WS_WPOOL = 18 * MiB;
constexpr size_t WS_WIN = 20 * MiB, WS_WOUT = 100 * MiB, WS_WGU2 = 132 * MiB, WS_WD2 = 304 * MiB;
constexpr size_t WS_XB = 390 * MiB;
constexpr size_t WS_WGU1 = 518 * MiB, WS_WD1 = 690 * MiB, WS_ACT = 776 * MiB;
constexpr size_t WS_QROW = 518 * MiB, WS_KROW = 582 * MiB, WS_KDT = 646 * MiB  , WS_GS = 774 * MiB, WS_PB = 838 * MiB, WS_POOLED = 902 * MiB;
constexpr size_t WS_ACAT = 966 * MiB, WS_BCAT = 1158 * MiB, WS_END = 1350 * MiB;
constexpr size_t WS_MIX = 1350 * MiB, WS_END2 = 1478 * MiB;
static_assert(WS_WIN + (size_t)PROJ * DM * 2 <= WS_WOUT && WS_WOUT + (size_t)DM * DM * 2 <= WS_WGU2 && WS_WGU2 + (size_t)2 * FF * DM * 2 <= WS_WD2 && WS_WD2 + (size_t)DM * FF * 2 <= WS_XB, "weights map");
static_assert(WS_XB + (size_t)S_ * DM * 2 <= WS_WGU1 && WS_WGU1 + (size_t)2 * FF * DM * 2 <= WS_WD1 && WS_WD1 + (size_t)DM * FF * 2 <= WS_ACT && WS_ACT + (size_t)S_ * FF * 2 <= WS_END, "ffn map");
static_assert(WS_ACAT + (size_t)NH * S_ * KCAT * 2 <= WS_BCAT && WS_BCAT + (size_t)NH * NCH * HD * KCAT * 2 <= WS_END && WS_POOLED + (size_t)S_ * PD * 2 <= WS_ACAT, "mixer map");
constexpr int CW_BAR = 4096;
constexpr int CW_RSQ = 16384;

constexpr int RING_OFF = 0, RING_BYTES = 131072;
constexpr int LDS_BYTES = 147456;
constexpr int EPI_SCR_OFF = 135168;
constexpr int MISC_OFF = LDS_BYTES - 256;
constexpr int TR_LD = 65, TR_BYTES = 64 * TR_LD * 4;
static_assert(NWAVES * TR_BYTES <= EPI_SCR_OFF + 4096 && EPI_SCR_OFF + 4096 <= MISC_OFF, "LDS map");

#define GAS __attribute__((address_space(1)))
#define LAS __attribute__((address_space(3)))
typedef unsigned short bf16;
typedef unsigned v4u __attribute__((ext_vector_type(4)));
typedef unsigned v2u __attribute__((ext_vector_type(2)));
typedef float f32x4 __attribute__((ext_vector_type(4)));
typedef GAS unsigned gu32;
#define RLX_AGENT __ATOMIC_RELAXED, __HIP_MEMORY_SCOPE_AGENT
#define LDS_WAIT() asm volatile("s_waitcnt lgkmcnt(0)" ::: "memory")
#define VM_WAIT() asm volatile("s_waitcnt vmcnt(0)" ::: "memory")
__device__ __forceinline__ unsigned f2bf(float f) { unsigned u = __builtin_bit_cast(unsigned, f); return (u + 0x7fffu + ((u >> 16) & 1u)) >> 16; }
typedef __bf16 bf16x2_t __attribute__((ext_vector_type(2)));
typedef float f32x2_t __attribute__((ext_vector_type(2)));
__device__ __forceinline__ unsigned pk2t(float lo, float hi) { const f32x2_t v = {lo, hi}; return __builtin_bit_cast(unsigned, __builtin_convertvector(v, bf16x2_t)); }
__device__ __forceinline__ unsigned pk2(float lo, float hi) { return pg8::cvt_pk_bf16(lo, hi); }
__device__ __forceinline__ float bf2f(unsigned h) { return __builtin_bit_cast(float, h << 16); }
__device__ __forceinline__ float fast_exp2(float x) { return __builtin_amdgcn_exp2f(x); }
__device__ __forceinline__ float silu_f(float x) { return x * __builtin_amdgcn_rcpf(1.0f + fast_exp2(-1.4426950408889634f * x)); }
__device__ __forceinline__ float log2_sigmoid(float x) { return -log1pf(expf(-x)) * 1.4426950408889634f; }

#define XB_TMO      128
#define XB_XCNT(j)  (256  + 64 * (j))
#define XB_XSUB(j)  (1280 + 64 * (j))
#define XB_XGEN(j)  (2304 + 64 * (j))
#define XB_TOP      3328
#define XB_TOPGEN   3392
#define XCD_BAR_WORDS 3456
#define XB_SPIN_CAP (1u << 18)

__device__ __forceinline__ unsigned xb_ld(unsigned* p)              { return __hip_atomic_load(p, __ATOMIC_RELAXED, __HIP_MEMORY_SCOPE_AGENT); }
__device__ __forceinline__ unsigned xb_add(unsigned* p, unsigned v) { return __hip_atomic_fetch_add(p, v, __ATOMIC_RELAXED, __HIP_MEMORY_SCOPE_AGENT); }
__device__ __forceinline__ unsigned xb_xcc_id() { return (unsigned)__builtin_amdgcn_s_getreg((3 << 11) | 20) & 0xFu; }
#define XB_SPIN(cond, bar) do { unsigned _sp = 0; while (cond) { __builtin_amdgcn_s_sleep(1); \
    if ((++_sp & 255u) == 0u) { if (xb_ld(&(bar)[XB_TMO])) break; if (_sp > XB_SPIN_CAP) { atomicAdd(&(bar)[XB_TMO], 1u); break; } } } } while (0)

struct XcdBarrier {
    unsigned* bar; unsigned x;
    volatile LAS unsigned* st;
};
__device__ __forceinline__ XcdBarrier xcd_barrier_post(unsigned* bar, volatile LAS unsigned* st) {
    XcdBarrier b; b.bar = bar; b.x = xb_xcc_id(); b.st = st;
    if (threadIdx.x == 0) (void)xb_add(&bar[XB_XCNT(b.x)], 1u);
    return b;
}
__device__ __forceinline__ void xcd_barrier_complete(unsigned* bar, unsigned x, unsigned& nloc, unsigned& nx) {
    const unsigned G = gridDim.x * gridDim.y * gridDim.z;
    unsigned sum, cnt, mine, sp = 0u;
    for (;;) {
        sum = 0u; cnt = 0u; mine = 0u;
#pragma unroll
        for (unsigned j = 0; j < 16; ++j) { const unsigned c = xb_ld(&bar[XB_XCNT(j)]); sum += c; cnt += (c > 0u) ? 1u : 0u; mine = (j == x) ? c : mine; }
        if (sum == G) break;
        __builtin_amdgcn_s_sleep(1);
        if ((++sp & 255u) == 0u) { if (xb_ld(&bar[XB_TMO])) break; if (sp > XB_SPIN_CAP) { atomicAdd(&bar[XB_TMO], 1u); break; } }
    }
    nloc = mine > 0u ? mine : 1u; nx = cnt > 0u ? cnt : 1u;
}
__device__ __forceinline__ void xcd_barrier(const XcdBarrier& b) {
    asm volatile("s_waitcnt vmcnt(0)" ::: "memory");
    __syncthreads();
    if (threadIdx.x == 0) {
        unsigned* bar = b.bar;
        __builtin_amdgcn_s_waitcnt(0);
        unsigned nloc = b.st[0], nx = b.st[1];
        if (nloc == 0u) { xcd_barrier_complete(bar, b.x, nloc, nx); b.st[0] = nloc; b.st[1] = nx; }
        const unsigned old = xb_add(&bar[XB_XSUB(b.x)], 1u);
        const unsigned gen = old / nloc;
        if (old + 1u == (gen + 1u) * nloc) {
            __builtin_amdgcn_fence(__ATOMIC_RELEASE, "agent");
            asm volatile("s_waitcnt vmcnt(0)" ::: "memory");
            const unsigned og = xb_add(&bar[XB_TOP], 1u);
            const unsigned tg = og / nx;
            if (og + 1u == (tg + 1u) * nx) xb_add(&bar[XB_TOPGEN], 1u);
            else XB_SPIN(xb_ld(&bar[XB_TOPGEN]) == tg, bar);
            __builtin_amdgcn_fence(__ATOMIC_ACQUIRE, "agent");
            xb_add(&bar[XB_XGEN(b.x)], 1u);
            asm volatile("s_waitcnt vmcnt(0)" ::: "memory");
        } else {
            XB_SPIN(xb_ld(&bar[XB_XGEN(b.x)]) == gen, bar);
            __builtin_amdgcn_fence(__ATOMIC_ACQUIRE, "agent");
            asm volatile("s_waitcnt vmcnt(0)" ::: "memory");
        }
    }
    __syncthreads();
}

using pg8::Unit;
typedef pg8::f32x4 accv;

__device__ __forceinline__ v4u pack8(const accv& v0, const accv& v1) { v4u w; w.x = pk2(v0[0], v0[1]); w.y = pk2(v0[2], v0[3]); w.z = pk2(v1[0], v1[1]); w.w = pk2(v1[2], v1[3]); return w; }

struct EpiGateUp {
    static constexpr bool PERM = true;
    const float* rowsq; bf16* act;
    __device__ __forceinline__ void operator()(const accv (&acc)[2][2][4][2], const Unit& u, int wr, int wc, int fr, int fq) const {
        const int row0 = u.pm * 256 + wr * 64 + fr, col0 = u.pn * 128 + wc * 32 + 8 * fq;
#pragma unroll
        for (int ai = 0; ai < 2; ++ai)
#pragma unroll
            for (int m = 0; m < 4; ++m) { const int row = row0 + ai * 128 + m * 16; const float rs = 1.0f / sqrtf(rowsq[row] * (1.0f / DM) + EPS);
                accv o[2];
#pragma unroll
                for (int n = 0; n < 2; ++n)
#pragma unroll
                    for (int j = 0; j < 4; ++j) { const float g = acc[ai][0][m][n][j] * rs, up = acc[ai][1][m][n][j] * rs; o[n][j] = silu_f(g) * up; }
                *(v4u*)(act + (size_t)row * FF + col0) = pack8(o[0], o[1]); }
    }
};

__device__ __forceinline__ void unpack8(const v4u& w, accv& a, accv& b) { a[0] = bf2f(w.x & 0xffffu); a[1] = bf2f(w.x >> 16); a[2] = bf2f(w.y & 0xffffu); a[3] = bf2f(w.y >> 16);
    b[0] = bf2f(w.z & 0xffffu); b[1] = bf2f(w.z >> 16); b[2] = bf2f(w.w & 0xffffu); b[3] = bf2f(w.w >> 16); }
struct EpiResid {
    static constexpr bool PERM = true;
    bf16* xs; float* rowsq; float scale;
    __device__ __forceinline__ void operator()(const accv (&acc)[2][2][4][2], const Unit& u, int wr, int wc, int fr, int fq) const {
        const int row0 = u.pm * 256 + wr * 64 + fr, col0 = u.pn * 256 + wc * 32 + 8 * fq;
        v4u xo[2][4][2];
#pragma unroll
        for (int ai = 0; ai < 2; ++ai)
#pragma unroll
            for (int m = 0; m < 4; ++m)
#pragma unroll
                for (int bj = 0; bj < 2; ++bj) xo[ai][m][bj] = *(const v4u*)(xs + (size_t)(row0 + ai * 128 + m * 16) * DM + col0 + bj * 128);
        asm volatile("" ::: "memory");
#pragma unroll
        for (int ai = 0; ai < 2; ++ai)
#pragma unroll
            for (int m = 0; m < 4; ++m) { const int row = row0 + ai * 128 + m * 16; const size_t off = (size_t)row * DM + col0; float ss = 0.f;
#pragma unroll
                for (int bj = 0; bj < 2; ++bj) { accv v0, v1; unpack8(xo[ai][m][bj], v0, v1);
                    v0 = v0 + acc[ai][bj][m][0] * scale; v1 = v1 + acc[ai][bj][m][1] * scale;
                    ss += (v0[0] * v0[0] + v0[1] * v0[1]) + (v0[2] * v0[2] + v0[3] * v0[3]) + (v1[0] * v1[0] + v1[1] * v1[1]) + (v1[2] * v1[2] + v1[3] * v1[3]);
                    *(v4u*)(xs + off + bj * 128) = pack8(v0, v1); }
                ss += __shfl_xor(ss, 16); ss += __shfl_xor(ss, 32);
                if (fq == 0) atomicAdd(rowsq + row, ss); }
    }
};

__device__ __forceinline__ float dpp_xor1(float v) { return __builtin_bit_cast(float, __builtin_amdgcn_mov_dpp(__builtin_bit_cast(int, v), 0xB1, 0xF, 0xF, true)); }
__device__ __forceinline__ void tstore2(bf16* p, float x0, float x1, bool odd) {
    const float recv = dpp_xor1(odd ? x0 : x1);
    *(unsigned*)p = pk2(odd ? recv : x0, odd ? x1 : recv);
}
struct EpiZ {
    static constexpr bool PERM = true;
    const float* rowsq; const float* cs; const float* l2tab;
    bf16 *qrow, *krow, *kdt, *gs, *pb, *acat, *bcat;
    __device__ __forceinline__ void operator()(const accv (&acc)[2][2][4][2], const Unit& u, int wr, int wc, int fr, int fq) const {
        const int type = u.pn >> 3, h = u.pn & 7, c = u.pm;
        const int i0 = wr * 64 + fr, d1 = wc * 32 + 8 * fq;
        const bool odd = (fr & 1) != 0;
        float rsv[2][4];
#pragma unroll
        for (int ai = 0; ai < 2; ++ai)
#pragma unroll
            for (int m = 0; m < 4; ++m) rsv[ai][m] = rowsq[c * 256 + i0 + ai * 128 + m * 16];
#pragma unroll
        for (int ai = 0; ai < 2; ++ai)
#pragma unroll
            for (int m = 0; m < 4; ++m) rsv[ai][m] = 1.0f / sqrtf(rsv[ai][m] * (1.0f / DM) + EPS);
        if (type <= 1) {
            float l2a = l2tab[h], l2b = l2tab[8 + h];
            accv tc[2][2], ts[2][2];
            { const size_t o = (size_t)(c * 256 + i0) * 128 + d1; tc[0][0] = *(const accv*)(cs + o); tc[0][1] = *(const accv*)(cs + o + 4); ts[0][0] = *(const accv*)(cs + (size_t)S_ * 128 + o); ts[0][1] = *(const accv*)(cs + (size_t)S_ * 128 + o + 4); }
#pragma unroll
            for (int ai = 0; ai < 2; ++ai)
#pragma unroll
                for (int m = 0; m < 4; ++m) { const int g = ai * 4 + m, cb = g & 1, i = i0 + ai * 128 + m * 16, s = c * 256 + i;
                    if (g < 7) { const int in = i0 + ((g + 1) >> 2) * 128 + ((g + 1) & 3) * 16; const size_t o = (size_t)(c * 256 + in) * 128 + d1;
                        tc[cb ^ 1][0] = *(const accv*)(cs + o); tc[cb ^ 1][1] = *(const accv*)(cs + o + 4); ts[cb ^ 1][0] = *(const accv*)(cs + (size_t)S_ * 128 + o); ts[cb ^ 1][1] = *(const accv*)(cs + (size_t)S_ * 128 + o + 4); }
                    const float rs = rsv[ai][m];
                    accv r1[2], r2[2];
                    r1[0] = acc[ai][0][m][0] * tc[cb][0] - acc[ai][1][m][0] * ts[cb][0]; r1[1] = acc[ai][0][m][1] * tc[cb][1] - acc[ai][1][m][1] * ts[cb][1];
                    r2[0] = acc[ai][0][m][0] * ts[cb][0] + acc[ai][1][m][0] * tc[cb][0]; r2[1] = acc[ai][0][m][1] * ts[cb][1] + acc[ai][1][m][1] * tc[cb][1];
                    if (type == 0) {
                        const size_t o = (size_t)s * RD + h * 256 + d1;
                        *(v4u*)(qrow + o) = pack8(r1[0] * rs, r1[1] * rs); *(v4u*)(qrow + o + 128) = pack8(r2[0] * rs, r2[1] * rs);
                    } else {
                        const float rk = rs * 0.0625f;
                        const size_t o = (size_t)s * RD + h * 256 + d1;
                        *(v4u*)(krow + o) = pack8(r1[0] * rk, r1[1] * rk); *(v4u*)(krow + o + 128) = pack8(r2[0] * rk, r2[1] * rk);
                        const float sf = rk * fast_exp2(l2a * (float)(CH - 1 - i)), sb = rk * fast_exp2(l2b * (float)i);
                        bf16* tf = kdt + ((size_t)h * 256 + d1 + (odd ? 1 : 0)) * S_ + s - (odd ? 1 : 0); bf16* tb = tf + (size_t)RD * S_;
#pragma unroll
                        for (int n = 0; n < 2; ++n)
#pragma unroll
                            for (int j = 0; j < 4; j += 2) { const size_t t = (size_t)(4 * n + j) * S_;
                                tstore2(tf + t, r1[n][j] * sf, r1[n][j + 1] * sf, odd); tstore2(tf + t + (size_t)128 * S_, r2[n][j] * sf, r2[n][j + 1] * sf, odd);
                                tstore2(tb + t, r1[n][j] * sb, r1[n][j + 1] * sb, odd); tstore2(tb + t + (size_t)128 * S_, r2[n][j] * sb, r2[n][j + 1] * sb, odd); }
                    }
                    asm volatile("" : "+v"(l2a), "+v"(l2b) :: "memory"); }
        } else if (type == 2) {
            bf16* base = bcat + ((size_t)(h * NCH + c) * 256 + d1 + (odd ? 1 : 0)) * KCAT + 512 - (odd ? 1 : 0);
#pragma unroll
            for (int ai = 0; ai < 2; ++ai)
#pragma unroll
                for (int m = 0; m < 4; ++m) { const int i = i0 + ai * 128 + m * 16; const float rs = rsv[ai][m];
#pragma unroll
                    for (int bj = 0; bj < 2; ++bj)
#pragma unroll
                        for (int n = 0; n < 2; ++n)
#pragma unroll
                            for (int j = 0; j < 4; j += 2) tstore2(base + (size_t)(bj * 128 + 4 * n + j) * KCAT + i, acc[ai][bj][m][n][j] * rs, acc[ai][bj][m][n][j + 1] * rs, odd); }
        } else {
            bf16* dst = (type == 3) ? gs : pb;
#pragma unroll
            for (int ai = 0; ai < 2; ++ai)
#pragma unroll
                for (int m = 0; m < 4; ++m) { const int i = i0 + ai * 128 + m * 16, s = c * 256 + i; const float rs = rsv[ai][m];
#pragma unroll
                    for (int bj = 0; bj < 2; ++bj) { accv v0 = acc[ai][bj][m][0] * rs, v1 = acc[ai][bj][m][1] * rs;
                        if (type == 3) {
#pragma unroll
                            for (int j = 0; j < 4; ++j) { v0[j] = silu_f(v0[j]); v1[j] = silu_f(v1[j]); } }
                        *(v4u*)(dst + (size_t)s * RD + h * 256 + bj * 128 + d1) = pack8(v0, v1); } }
        }
    }
};

struct EpiKV {
    static constexpr bool PERM = true;
    bf16* bcat;
    __device__ __forceinline__ void operator()(const accv (&acc)[2][2][4][2], const Unit& u, int wr, int wc, int fr, int fq) const {
        bf16* base = bcat + ((size_t)(u.pn * NCH + u.pm) * 256) * KCAT + 256 - 256 * u.z + wc * 32 + 8 * fq;
        const int r0 = wr * 64 + fr;
#pragma unroll
        for (int ai = 0; ai < 2; ++ai)
#pragma unroll
            for (int m = 0; m < 4; ++m) { bf16* rp = base + (size_t)(r0 + ai * 128 + m * 16) * KCAT;
#pragma unroll
                for (int bj = 0; bj < 2; ++bj) *(v4u*)(rp + bj * 128) = pack8(acc[ai][bj][m][0], acc[ai][bj][m][1]); }
    }
};

struct EpiS {
    static constexpr bool PERM = true;
    const float* l2tab; bf16* acat;
    __device__ __forceinline__ void operator()(const accv (&acc)[2][2][4][2], const Unit& u, int wr, int wc, int fr, int fq) const {
        const int h = u.pn, c = u.pm;
        float l2a = l2tab[h], l2b = l2tab[8 + h];
        const int i0 = wr * 64 + fr, j0 = wc * 32 + 8 * fq;
        bf16* base = acat + (size_t)c * 256 * RD + h * 256 + j0;
#pragma unroll
        for (int ai = 0; ai < 2; ++ai)
#pragma unroll
            for (int m = 0; m < 4; ++m) { const int i = i0 + ai * 128 + m * 16;
#pragma unroll
                for (int bj = 0; bj < 2; ++bj) { accv v[2];
#pragma unroll
                    for (int n = 0; n < 2; ++n)
#pragma unroll
                        for (int j = 0; j < 4; ++j) { const float dd = (float)(i - (bj * 128 + j0 + 4 * n + j)); const float e = l2a * fmaxf(dd, 0.f) - l2b * fminf(dd, 0.f); v[n][j] = acc[ai][bj][m][n][j] * fast_exp2(e); }
                    *(v4u*)(base + (size_t)i * RD + bj * 128) = pack8(v[0], v[1]); }
                asm volatile("" : "+v"(l2a), "+v"(l2b) :: "memory"); }
    }
};

struct EpiPool {
    static constexpr bool PERM = true;
    const float* pscale; bf16* mix;
    __device__ __forceinline__ void operator()(const accv (&acc)[2][2][4][2], const Unit& u, int wr, int wc, int fr, int fq) const {
        const int row0 = u.pm * 256 + wr * 64 + fr, colp = u.pn * 256 + wc * 32 + 8 * fq;
        accv sc[2][2];
#pragma unroll
        for (int bj = 0; bj < 2; ++bj)
#pragma unroll
            for (int n = 0; n < 2; ++n) sc[bj][n] = *(const accv*)(pscale + colp + bj * 128 + 4 * n);
#pragma unroll
        for (int ai = 0; ai < 2; ++ai)
#pragma unroll
            for (int m = 0; m < 4; ++m) { bf16* rp = mix + (size_t)(row0 + ai * 128 + m * 16) * DM + RD + colp;
#pragma unroll
                for (int bj = 0; bj < 2; ++bj) *(v4u*)(rp + bj * 128) = pack8(acc[ai][bj][m][0] * sc[bj][0], acc[ai][bj][m][1] * sc[bj][1]); }
    }
};

struct EpiOut {
    static constexpr bool PERM = true;
    const float* hnorm; const bf16* gs; bf16* mix; LAS float* scr; const float* l2tab;
    __device__ __forceinline__ void seg_scale(accv (&acc)[2][2][4][2], const Unit& u, int t, int wr, int fr) const {
        const float l2a = l2tab[u.pn], l2b = l2tab[8 + u.pn]; const int i0 = wr * 64 + fr;
#pragma unroll
        for (int ai = 0; ai < 2; ++ai)
#pragma unroll
            for (int m = 0; m < 4; ++m) { const float i = (float)(i0 + ai * 128 + m * 16);
                const float e = (t == 4) ? (l2b * ((float)CH - i) - l2a * (i + 1.0f)) : (l2a * (i + 1.0f)); const float f = fast_exp2(e);
#pragma unroll
                for (int bj = 0; bj < 2; ++bj)
#pragma unroll
                    for (int n = 0; n < 2; ++n) acc[ai][bj][m][n] *= f; }
    }
    __device__ __forceinline__ void operator()(const accv (&acc)[2][2][4][2], const Unit& u, int wr, int wc, int fr, int fq) const {
        const int h = u.pn, c = u.pm; const int i0 = wr * 64 + fr, e0 = wc * 32 + 8 * fq;
#pragma unroll
        for (int ai = 0; ai < 2; ++ai)
#pragma unroll
            for (int m = 0; m < 4; ++m) { float ss = 0.f;
#pragma unroll
                for (int bj = 0; bj < 2; ++bj)
#pragma unroll
                    for (int n = 0; n < 2; ++n) { const accv x = acc[ai][bj][m][n]; ss += (x[0] * x[0] + x[1] * x[1]) + (x[2] * x[2] + x[3] * x[3]); }
                ss += __shfl_xor(ss, 16); ss += __shfl_xor(ss, 32);
                if (fq == 0) scr[(i0 + ai * 128 + m * 16) * 4 + wc] = ss; }
        asm volatile("s_waitcnt lgkmcnt(0)" ::: "memory"); __builtin_amdgcn_s_barrier(); asm volatile("" ::: "memory");
        accv hn[2][2];
#pragma unroll
        for (int bj = 0; bj < 2; ++bj)
#pragma unroll
            for (int n = 0; n < 2; ++n) hn[bj][n] = *(const accv*)(hnorm + h * 256 + bj * 128 + e0 + 4 * n);
#pragma unroll
        for (int ai = 0; ai < 2; ++ai)
#pragma unroll
            for (int m = 0; m < 4; ++m) { const int i = i0 + ai * 128 + m * 16; const accv p = *(const LAS accv*)(scr + i * 4);
                const float rn = 1.0f / sqrtf(((p[0] + p[1]) + (p[2] + p[3])) * (1.0f / HD) + EPS);
                const size_t o = (size_t)(c * 256 + i) * RD + h * 256 + e0;
#pragma unroll
                for (int bj = 0; bj < 2; ++bj) { const v4u gv = *(const v4u*)(gs + o + bj * 128);
                    accv g0, g1; g0[0] = bf2f(gv.x & 0xffffu); g0[1] = bf2f(gv.x >> 16); g0[2] = bf2f(gv.y & 0xffffu); g0[3] = bf2f(gv.y >> 16);
                    g1[0] = bf2f(gv.z & 0xffffu); g1[1] = bf2f(gv.z >> 16); g1[2] = bf2f(gv.w & 0xffffu); g1[3] = bf2f(gv.w >> 16);
                    *(v4u*)(mix + (size_t)(c * 256 + i) * DM + h * 256 + bj * 128 + e0) = pack8(acc[ai][bj][m][0] * rn * hn[bj][0] * g0, acc[ai][bj][m][1] * rn * hn[bj][1] * g1); } }
        asm volatile("s_waitcnt lgkmcnt(0)" ::: "memory"); __builtin_amdgcn_s_barrier(); asm volatile("" ::: "memory");
    }
};

struct SchedKV {
    int G, c;
    __device__ __forceinline__ bool next(int i, Unit& u) const { const int L = i * G + c; if (L >= NH * NCH * 2) return false; u.z = L & 1; u.pm = (L >> 1) & (NCH - 1); u.pn = L >> 7; return true; }
    __device__ __forceinline__ size_t a_off(const Unit& u) const { return ((size_t)(u.pn * NCH + u.pm) * 256 * KCAT + 512) * 2; }
    __device__ __forceinline__ size_t b_off(const Unit& u) const { return ((size_t)u.z * RD * S_ + (size_t)u.pn * 256 * S_ + (size_t)u.pm * 256) * 2; }
};
struct SchedS {
    int G, c;
    __device__ __forceinline__ bool next(int i, Unit& u) const { const int L = i * G + c; if (L >= NH * NCH) return false; u.z = 0; u.pm = L & (NCH - 1); u.pn = L >> 6; return true; }
    __device__ __forceinline__ size_t a_off(const Unit& u) const { return ((size_t)u.pm * 256 * RD + (size_t)u.pn * 256) * 2; }
    __device__ __forceinline__ size_t b_off(const Unit& u) const { return a_off(u); }
};
struct SchedPool {
    int G, c;
    __device__ __forceinline__ bool next(int i, Unit& u) const { const int L = i * G + c; if (L >= NCH * 8) return false; u.z = 0; u.pn = L & 7; u.pm = L >> 3; return true; }
    __device__ __forceinline__ size_t a_off(const Unit& u) const { return ((size_t)u.pm * 256 * PD + (size_t)(u.pn >> 1) * 512) * 2; }
    __device__ __forceinline__ size_t b_off(const Unit& u) const { return ((size_t)u.pn * 256 * 512) * 2; }
};
struct SchedOut {
    int G, c;
    __device__ __forceinline__ bool next(int i, Unit& u) const { const int L = i * G + c; if (L >= NH * NCH) return false; u.z = 0; u.pm = L & (NCH - 1); u.pn = L >> 6; return true; }
    __device__ __forceinline__ size_t a_off(const Unit& u) const { return ((size_t)u.pm * 256 * RD + (size_t)u.pn * 256) * 2; }
    __device__ __forceinline__ size_t b_off(const Unit& u) const { return ((size_t)(u.pn * NCH + u.pm) * 256 * KCAT) * 2; }
};

struct Frame {
    LAS unsigned char* lds;
    volatile LAS unsigned* MISC;
    int tid, lane, wave, G;
};

__device__ __forceinline__ float wave_sum(float v) {
#pragma unroll
    for (int o = 1; o < 64; o <<= 1) v += __shfl_xor(v, o);
    return v;
}

__device__ __forceinline__ void tr_matrix(Frame& F, const float* __restrict__ W, int K, int N, const float* __restrict__ gain, bf16* WT, int blk, int dblk, int doff, int gwi, int ngw) {
    LAS float* scr = (LAS float*)(F.lds + F.wave * TR_BYTES);
    const int nblk = N / 64, nitems = (K / 64) * nblk, lane = F.lane;
    const int lr = lane >> 4, lc = (lane & 15) * 4;
    int it = gwi; if (it >= nitems) return;
    f32x4 v[16]; float gs[16];
    int k0 = 64 * (it / nblk), n0 = 64 * (it % nblk);
#pragma unroll
    for (int i = 0; i < 16; ++i) { v[i] = *(const f32x4*)(W + (size_t)(k0 + lr + 4 * i) * N + n0 + lc); gs[i] = gain ? gain[k0 + lr + 4 * i] : 1.0f; }
    for (;;) {
#pragma unroll
        for (int i = 0; i < 16; ++i) { LAS float* d = scr + (lr + 4 * i) * TR_LD + lc; d[0] = v[i][0] * gs[i]; d[1] = v[i][1] * gs[i]; d[2] = v[i][2] * gs[i]; d[3] = v[i][3] * gs[i]; }
        const int ck0 = k0, cn0 = n0; const int itn = it + ngw; const bool more = itn < nitems;
        if (more) { k0 = 64 * (itn / nblk); n0 = 64 * (itn % nblk);
#pragma unroll
            for (int i = 0; i < 16; ++i) { v[i] = *(const f32x4*)(W + (size_t)(k0 + lr + 4 * i) * N + n0 + lc); gs[i] = gain ? gain[k0 + lr + 4 * i] : 1.0f; } }
        LDS_WAIT(); asm volatile("" ::: "memory");
        const int cc = lane & 7;
        const int drow0 = (cn0 / blk) * dblk + doff + (cn0 % blk);
#pragma unroll
        for (int j = 0; j < 8; ++j) { const int n = (lane >> 3) + 8 * j; const LAS float* sp = scr + (8 * cc) * TR_LD + n;
            float t[8];
#pragma unroll
            for (int q = 0; q < 8; ++q) t[q] = sp[q * TR_LD];
            v4u o; o.x = pk2t(t[0], t[1]); o.y = pk2t(t[2], t[3]); o.z = pk2t(t[4], t[5]); o.w = pk2t(t[6], t[7]);
            *(v4u*)(WT + (size_t)(drow0 + n) * K + ck0 + 8 * cc) = o; }
        LDS_WAIT(); asm volatile("" ::: "memory");
        if (!more) break;
        it = itn;
    }
}

template <int W> __device__ __forceinline__ void pooled_block(const bf16* __restrict__ pbuf, bf16* __restrict__ pooled, int s0, int cv) {
    constexpr int RB = 8, LO = W / 2, HI = W - 1 - LO, NR = RB + W - 1;
    v4u raw[NR];
#pragma unroll
    for (int q = 0; q < NR; ++q) { const int r = s0 - LO + q; const int rc = r < 0 ? 0 : (r >= S_ ? S_ - 1 : r); raw[q] = *(const v4u*)(pbuf + (size_t)rc * PD + cv * 8); }
#pragma unroll
    for (int q = 0; q < NR; ++q) { const int r = s0 - LO + q; if (r < 0 || r >= S_) raw[q] = (v4u){0u, 0u, 0u, 0u}; }
    accv ra = {0.f, 0.f, 0.f, 0.f}, rb = {0.f, 0.f, 0.f, 0.f};
#pragma unroll
    for (int q = 0; q < W; ++q) { accv a, b; unpack8(raw[q], a, b); ra += a; rb += b; }
#pragma unroll
    for (int i = 0; i < RB; ++i) { const int s = s0 + i; int st = s - LO; st = st < 0 ? 0 : st; int en = s + HI + 1; en = en > S_ ? S_ : en; const float inv = 1.0f / (float)(en - st);
        accv sa, sb; unpack8(raw[i + LO], sa, sb);
        *(v4u*)(pooled + (size_t)s * PD + cv * 8) = pack8(ra * inv - sa, rb * inv - sb);
        if (i < RB - 1) { accv a, b, c, d; unpack8(raw[i + W], a, b); unpack8(raw[i], c, d); ra += a - c; rb += b - d; } }
}
struct Args { const float* in[19]; const int* pos; float* out; unsigned char* ws; int ph_lo, ph_hi; };
static_assert(sizeof(Args) == 19 * 8 + 8 + 8 + 8 + 8, "Args has no padding");

enum { IN_X = 0, IN_POS = 1, IN_F1N = 2, IN_F1G = 3, IN_F1U = 4, IN_F1D = 5, IN_MIXN = 6, IN_WIN = 7, IN_DECF = 8, IN_DECB = 9, IN_HNORM = 10, IN_POOLW = 11, IN_PSCALE = 12,
       IN_WOUT = 13, IN_F2N = 14, IN_F2G = 15, IN_F2U = 16, IN_F2D = 17, IN_FINN = 18 };
constexpr int NPHASE = 11;
#ifndef MK_DUP
#define MK_DUP (-1)
#endif
#ifndef MK_SUB
#define MK_SUB 0
#endif
#define SUBON(k) (!rep || MK_SUB == 0 || MK_SUB == (k))
#ifndef MK_PHASE_MASK
#define MK_PHASE_MASK 0x7ff
#endif

typedef const __attribute__((address_space(4))) Args* KArgs;
__device__ __forceinline__ KArgs kargs() { KArgs p = (KArgs)__builtin_amdgcn_kernarg_segment_ptr(); asm volatile("" : "+s"(p)); return p; }
#define GP(T, p) ((T*)(GAS T*)(p))
__device__ __forceinline__ void grid_sync(Frame& F) {
    KArgs ap = kargs(); XcdBarrier b; b.bar = (unsigned*)(GP(unsigned char, ap->ws) + WS_CTL) + CW_BAR; b.x = xb_xcc_id(); b.st = F.MISC + 8; xcd_barrier(b);
}

__global__ void __launch_bounds__(NWAVES * 64, 2) fwd_kernel(Args args) {
    extern __shared__ __attribute__((aligned(16))) unsigned char lds[];
    Frame F;
    F.lds = (LAS unsigned char*)lds;
    F.MISC = (volatile LAS unsigned*)(F.lds + MISC_OFF);
    F.tid = threadIdx.x; F.lane = F.tid & 63; F.wave = __builtin_amdgcn_readfirstlane(F.tid >> 6);
    F.G = gridDim.x;
    if (F.tid < 64) F.MISC[F.tid] = 0u;
    __syncthreads();
    { KArgs ap = kargs(); (void)xcd_barrier_post((unsigned*)(GP(unsigned char, ap->ws) + WS_CTL) + CW_BAR, F.MISC + 8); }
    const int lo = args.ph_lo, hi = args.ph_hi;
#define IN(k) (lo <= (k) && (k) < hi)
#define PHON(k) (((MK_PHASE_MASK) >> (k)) & 1)
#define SEAM(k) do { if (IN(k) && IN((k) + 1)) grid_sync(F); } while (0)
#if MK_DUP == 0
#define RL0 for (int rep = 0; rep < 2; ++rep)
#else
#define RL0 if (const int rep = 0; true)
#endif
#if MK_DUP == 1
#define RL1 for (int rep = 0; rep < 2; ++rep)
#else
#define RL1 if (const int rep = 0; true)
#endif
#if MK_DUP == 2
#define RL2 for (int rep = 0; rep < 2; ++rep)
#else
#define RL2 if (const int rep = 0; true)
#endif
#if MK_DUP == 3
#define RL3 for (int rep = 0; rep < 2; ++rep)
#else
#define RL3 if (const int rep = 0; true)
#endif
#if MK_DUP == 4
#define RL4 for (int rep = 0; rep < 2; ++rep)
#else
#define RL4 if (const int rep = 0; true)
#endif
#if MK_DUP == 5
#define RL5 for (int rep = 0; rep < 2; ++rep)
#else
#define RL5 if (const int rep = 0; true)
#endif
#if MK_DUP == 6
#define RL6 for (int rep = 0; rep < 2; ++rep)
#else
#define RL6 if (const int rep = 0; true)
#endif
#if MK_DUP == 7
#define RL7 for (int rep = 0; rep < 2; ++rep)
#else
#define RL7 if (const int rep = 0; true)
#endif
#if MK_DUP == 8
#define RL8 for (int rep = 0; rep < 2; ++rep)
#else
#define RL8 if (const int rep = 0; true)
#endif
#if MK_DUP == 9
#define RL9 for (int rep = 0; rep < 2; ++rep)
#else
#define RL9 if (const int rep = 0; true)
#endif
#if MK_DUP == 10
#define RL10 for (int rep = 0; rep < 2; ++rep)
#else
#define RL10 if (const int rep = 0; true)
#endif
#define PHASE(k) if (PHON(k) && IN(k)) RL##k
#define PHASE_ENV KArgs ap = kargs(); unsigned char* ws = GP(unsigned char, ap->ws); float* rsq = (float*)(ws + WS_CTL) + CW_RSQ; float* xres = GP(float, ap->out); bf16* xb = (bf16*)(ws + WS_XB); \
    float* const dum_rs = (float*)(ws + WS_TAB + 65536); (void)rsq; (void)xres; (void)xb; (void)dum_rs; if (rep) grid_sync(F)
#define AIN(k) GP(const float, ap->in[k])
    const int gw = blockIdx.x * NWAVES + F.wave, NGW = F.G * NWAVES;
    const int gt = blockIdx.x * (NWAVES * 64) + F.tid, NGT = F.G * NWAVES * 64;

    PHASE(0) { PHASE_ENV;
        tr_matrix(F, AIN(IN_F1G), DM, FF, AIN(IN_F1N), (bf16*)(ws + WS_WGU1), 128, 256, 0, gw, NGW);
        tr_matrix(F, AIN(IN_F1U), DM, FF, AIN(IN_F1N), (bf16*)(ws + WS_WGU1), 128, 256, 128, gw, NGW);
        tr_matrix(F, AIN(IN_F1D), FF, DM, nullptr, (bf16*)(ws + WS_WD1), DM, 0, 0, gw, NGW);
        tr_matrix(F, AIN(IN_F2G), DM, FF, AIN(IN_F2N), (bf16*)(ws + WS_WGU2), 128, 256, 0, gw, NGW);
        tr_matrix(F, AIN(IN_F2U), DM, FF, AIN(IN_F2N), (bf16*)(ws + WS_WGU2), 128, 256, 128, gw, NGW);
        tr_matrix(F, AIN(IN_F2D), FF, DM, nullptr, (bf16*)(ws + WS_WD2), DM, 0, 0, gw, NGW);
#pragma unroll 1
        for (int g = 0; g < 4; ++g) tr_matrix(F, AIN(IN_POOLW) + (size_t)g * 512 * 512, 512, 512, nullptr, (bf16*)(ws + WS_WPOOL) + (size_t)g * 512 * 512, 512, 0, 0, gw, NGW);
        const float* x = AIN(IN_X);
        for (int m = gw; m < S_; m += NGW) {
            const f32x4* xr = (const f32x4*)(x + (size_t)m * DM) + F.lane; float ss = 0.f;
            f32x4 xv[16];
#pragma unroll
            for (int j = 0; j < 16; ++j) xv[j] = xr[64 * j];
            asm volatile("" ::: "memory");
#pragma unroll
            for (int j = 0; j < 16; ++j) { const f32x4 a = xv[j];
                ss += (a[0] * a[0] + a[1] * a[1]) + (a[2] * a[2] + a[3] * a[3]);
                v2u pa; pa.x = pk2(a[0], a[1]); pa.y = pk2(a[2], a[3]);
                *((v2u*)(xb + (size_t)m * DM) + F.lane + 64 * j) = pa; }
            ss = wave_sum(ss);
            if (F.lane == 0) rsq[m] = ss;
        }
        if (gt < 16) ((float*)(ws + WS_TAB))[gt] = log2_sigmoid((gt < 8 ? AIN(IN_DECF) : AIN(IN_DECB))[gt & 7]);
        float* cst = (float*)(ws + WS_CS); const int* pos = GP(const int, ap->pos);
        for (int t = gt; t < S_ * 128; t += NGT) { const int s = t >> 7, i = t & 127;
            const float pw = (float)pow(10000.0, (double)((float)i * (1.0f / 128.0f))); const float fr = 1.0f / pw;
            const float ang = (float)pos[s] * fr;
            const double rev = (double)ang * 0.15915494309189533577; const float fr_rev = (float)(rev - rint(rev));
            cst[t] = __builtin_amdgcn_cosf(fr_rev); cst[(size_t)S_ * 128 + t] = __builtin_amdgcn_sinf(fr_rev); }
    }
    SEAM(0);

    PHASE(1) { PHASE_ENV;
        pg8::Gemm g{xb, (const bf16*)(ws + WS_WGU1), DM, DM, DM}; pg8::SchedGrid S; S.init(S_ / 256, 2 * FF / 256, F.G, (int)blockIdx.x, DM, DM);
        EpiGateUp E{rsq, (bf16*)(ws + WS_ACT)};
        pg8::gemm_phase(F.lds + RING_OFF, g, S, E);
        if (!rep) {
            const int nun = (S_ / 256) * (2 * FF / 256), rem = nun % F.G, first = rem, nidle = F.G - first;
            if ((int)blockIdx.x >= first) { const int gwi = ((int)blockIdx.x - first) * NWAVES + F.wave, ngw = nidle * NWAVES;
                tr_matrix(F, AIN(IN_WIN), DM, PROJ, AIN(IN_MIXN), (bf16*)(ws + WS_WIN), PROJ, 0, 0, gwi, ngw);
                tr_matrix(F, AIN(IN_WOUT), DM, DM, nullptr, (bf16*)(ws + WS_WOUT), DM, 0, 0, gwi, ngw); }
        }
    }
    SEAM(1);
    PHASE(2) { PHASE_ENV;
        pg8::Gemm g{(const bf16*)(ws + WS_ACT), (const bf16*)(ws + WS_WD1), FF, FF, FF}; pg8::SchedGrid S; S.init(S_ / 256, DM / 256, F.G, (int)blockIdx.x, FF, FF, 2);
        EpiResid E{rep ? (bf16*)(ws + WS_ACAT) : xb, rep ? dum_rs : rsq + S_, 0.5f};
        pg8::gemm_phase(F.lds + RING_OFF, g, S, E);
    }
    SEAM(2);
    PHASE(3) { PHASE_ENV;
        pg8::Gemm g{xb, (const bf16*)(ws + WS_WIN), DM, DM, DM}; pg8::SchedGrid S; S.init(S_ / 256, PROJ / 256, F.G, (int)blockIdx.x, DM, DM);
        EpiZ E{rsq + S_, (const float*)(ws + WS_CS), (const float*)(ws + WS_TAB), (bf16*)(ws + WS_QROW), (bf16*)(ws + WS_KROW), (bf16*)(ws + WS_KDT), (bf16*)(ws + WS_GS), (bf16*)(ws + WS_PB),
               (bf16*)(ws + WS_ACAT), (bf16*)(ws + WS_BCAT)};
        pg8::gemm_phase(F.lds + RING_OFF, g, S, E);
    }
    SEAM(3);
    PHASE(4) { PHASE_ENV;
        if (SUBON(1)) {   const bf16* pbuf = (const bf16*)(ws + WS_PB); bf16* pooled = (bf16*)(ws + WS_POOLED);
            for (int t = gt; t < (S_ / 8) * (PD / 8); t += NGT) { const int s0 = (t >> 8) * 8, cv = t & 255, grp = cv >> 6;
                if (grp == 0) pooled_block<2>(pbuf, pooled, s0, cv); else if (grp == 1) pooled_block<4>(pbuf, pooled, s0, cv);
                else if (grp == 2) pooled_block<8>(pbuf, pooled, s0, cv); else pooled_block<16>(pbuf, pooled, s0, cv); }
            VM_WAIT(); __syncthreads();
        }
        if (SUBON(2)) {   pg8::Gemm g{(const bf16*)(ws + WS_BCAT), (const bf16*)(ws + WS_KDT), KCAT, S_, CH}; SchedKV S{F.G, (int)blockIdx.x};
            EpiKV E{(bf16*)(ws + WS_BCAT)};
            pg8::gemm_phase(F.lds + RING_OFF, g, S, E); }
        if (SUBON(3)) {   pg8::Gemm g{(const bf16*)(ws + WS_QROW), (const bf16*)(ws + WS_KROW), RD, RD, HD}; SchedS S{F.G, (int)blockIdx.x};
            EpiS E{(const float*)(ws + WS_TAB), (bf16*)(ws + WS_ACAT)};
            pg8::gemm_phase(F.lds + RING_OFF, g, S, E); }
    }
    SEAM(4);
    PHASE(5) { PHASE_ENV;
        if (!rep) {   bf16* bcat = (bf16*)(ws + WS_BCAT);
            for (int t = gt; t < 2 * NH * HD * (HD / 8); t += NGT) { const int dir = t >> 16, rem = t & 65535, h = rem >> 13, e = (rem >> 5) & 255, dv = rem & 31;
                const float l2 = ((const float*)(ws + WS_TAB))[dir * 8 + h]; const float dC = fast_exp2(l2 * (float)CH);
                bf16* p0 = bcat + ((size_t)(h * NCH) * 256 + e) * KCAT + 256 - 256 * dir + dv * 8; const size_t cstep = (size_t)256 * KCAT;
                float run[8];
#pragma unroll
                for (int j = 0; j < 8; ++j) run[j] = 0.f;
#pragma unroll 1
                for (int cb = 0; cb < NCH; cb += 8) { v4u kv[8];
#pragma unroll
                    for (int q = 0; q < 8; ++q) { const int c = dir ? (NCH - 1 - (cb + q)) : (cb + q); kv[q] = *(const v4u*)(p0 + (size_t)c * cstep); }
#pragma unroll
                    for (int q = 0; q < 8; ++q) { const int c = dir ? (NCH - 1 - (cb + q)) : (cb + q);
                        v4u o; o.x = pk2(run[0], run[1]); o.y = pk2(run[2], run[3]); o.z = pk2(run[4], run[5]); o.w = pk2(run[6], run[7]);
                        *(v4u*)(p0 + (size_t)c * cstep) = o;
                        run[0] = run[0] * dC + bf2f(kv[q].x & 0xffffu); run[1] = run[1] * dC + bf2f(kv[q].x >> 16); run[2] = run[2] * dC + bf2f(kv[q].y & 0xffffu); run[3] = run[3] * dC + bf2f(kv[q].y >> 16);
                        run[4] = run[4] * dC + bf2f(kv[q].z & 0xffffu); run[5] = run[5] * dC + bf2f(kv[q].z >> 16); run[6] = run[6] * dC + bf2f(kv[q].w & 0xffffu); run[7] = run[7] * dC + bf2f(kv[q].w >> 16); } } }
            VM_WAIT(); __syncthreads();
        }
        {   pg8::Gemm g{(const bf16*)(ws + WS_POOLED), (const bf16*)(ws + WS_WPOOL), PD, 512, 512}; SchedPool S{F.G, (int)blockIdx.x};
            EpiPool E{AIN(IN_PSCALE), (bf16*)(ws + WS_MIX)};
            pg8::gemm_phase(F.lds + RING_OFF, g, S, E); }
    }
    SEAM(5);
    PHASE(6) { PHASE_ENV;
        pg8::Gemm g{(const bf16*)(ws + WS_QROW), (const bf16*)(ws + WS_BCAT), RD, KCAT, KCAT, (const bf16*)(ws + WS_ACAT)}; SchedOut S{F.G, (int)blockIdx.x};
        EpiOut E{AIN(IN_HNORM), (const bf16*)(ws + WS_GS), (bf16*)(ws + WS_MIX), (LAS float*)(F.lds + EPI_SCR_OFF), (const float*)(ws + WS_TAB)};
        pg8::gemm_phase<EpiOut, SchedOut, true>(F.lds + RING_OFF, g, S, E);
    }
    SEAM(6);
    PHASE(7) { PHASE_ENV;
        pg8::Gemm g{(const bf16*)(ws + WS_MIX), (const bf16*)(ws + WS_WOUT), DM, DM, DM}; pg8::SchedGrid S; S.init(S_ / 256, DM / 256, F.G, (int)blockIdx.x, DM, DM);
        EpiResid E{rep ? (bf16*)(ws + WS_ACAT) : xb, rep ? dum_rs : rsq + 2 * S_, 1.0f};
        pg8::gemm_phase(F.lds + RING_OFF, g, S, E);
    }
    SEAM(7);
    PHASE(8) { PHASE_ENV;
        pg8::Gemm g{xb, (const bf16*)(ws + WS_WGU2), DM, DM, DM}; pg8::SchedGrid S; S.init(S_ / 256, 2 * FF / 256, F.G, (int)blockIdx.x, DM, DM);
        EpiGateUp E{rsq + 2 * S_, (bf16*)(ws + WS_ACT)};
        pg8::gemm_phase(F.lds + RING_OFF, g, S, E);
    }
    SEAM(8);
    PHASE(9) { PHASE_ENV;
        pg8::Gemm g{(const bf16*)(ws + WS_ACT), (const bf16*)(ws + WS_WD2), FF, FF, FF}; pg8::SchedGrid S; S.init(S_ / 256, DM / 256, F.G, (int)blockIdx.x, FF, FF, 2);
        EpiResid E{rep ? (bf16*)(ws + WS_WGU1) : xb, rep ? dum_rs : rsq + 3 * S_, 0.5f};
        pg8::gemm_phase(F.lds + RING_OFF, g, S, E);
    }
    SEAM(9);
    PHASE(10) { PHASE_ENV;
        const float* fn = AIN(IN_FINN);
        const unsigned tmo = __hip_atomic_load((unsigned*)(ws + WS_CTL) + CW_BAR + XB_TMO, RLX_AGENT);
        for (int m = gw; m < S_; m += NGW) { float rs = 1.0f / sqrtf(rsq[3 * S_ + m] * (1.0f / DM) + EPS);
            if (tmo) rs = __builtin_nanf("");
            const v4u* xr = (const v4u*)(xb + (size_t)m * DM) + F.lane; f32x4* orow = (f32x4*)(xres + (size_t)m * DM);
            v4u xw[8];
#pragma unroll
            for (int j = 0; j < 8; ++j) xw[j] = xr[64 * j];
            asm volatile("" ::: "memory");
#pragma unroll
            for (int j = 0; j < 8; ++j) { accv a, b; unpack8(xw[j], a, b);
                const f32x4 g0 = *((const f32x4*)fn + 2 * (F.lane + 64 * j)), g1 = *((const f32x4*)fn + 2 * (F.lane + 64 * j) + 1);
                orow[2 * (F.lane + 64 * j)] = a * rs * g0; orow[2 * (F.lane + 64 * j) + 1] = b * rs * g1; } }
    }
#undef IN
#undef SEAM
}

#ifndef MK_N_LAUNCHES
#define MK_N_LAUNCHES 1
#endif
extern "C" void kernel_launch(void* const* d_in, const int* in_sizes, int n_in, void* d_out, int out_size, void* d_ws, size_t ws_size, hipStream_t stream) {
    static int grid = 0;
    if (grid == 0) {
        if (n_in != 19 || in_sizes[0] != S_ * DM || out_size != S_ * DM || ws_size < WS_END2) { fprintf(stderr, "kernel_launch: unexpected shapes (n_in %d, in0 %d, out %d, ws %zu); nothing launched\n", n_in, n_in > 0 ? in_sizes[0] : -1, out_size, ws_size); grid = -1; return; }
        int dev = 0, cus = 0, per_cu = 0;
        if (hipGetDevice(&dev) != hipSuccess || hipDeviceGetAttribute(&cus, hipDeviceAttributeMultiprocessorCount, dev) != hipSuccess) { fprintf(stderr, "kernel_launch: device query failed\n"); grid = -1; return; }
        if (hipFuncSetAttribute((const void*)fwd_kernel, hipFuncAttributeMaxDynamicSharedMemorySize, LDS_BYTES) != hipSuccess) { fprintf(stderr, "kernel_launch: hipFuncSetAttribute failed\n"); grid = -1; return; }
        if (hipOccupancyMaxActiveBlocksPerMultiprocessor(&per_cu, (const void*)fwd_kernel, NWAVES * 64, LDS_BYTES) != hipSuccess || per_cu < 1) { fprintf(stderr, "kernel_launch: occupancy query reports %d workgroups per CU\n", per_cu); per_cu = 1; }
        (void)hipGetLastError();
        grid = cus;
    }
    if (grid < 0) return;
    if (hipMemsetAsync((char*)d_ws + WS_CTL, 0, CTL_ZERO_BYTES, stream) != hipSuccess) { fprintf(stderr, "kernel_launch: memset failed\n"); return; }
    Args a{};
    for (int i = 0; i < 19; ++i) a.in[i] = (const float*)d_in[i];
    a.pos = (const int*)d_in[IN_POS]; a.out = (float*)d_out; a.ws = (unsigned char*)d_ws;
#if MK_N_LAUNCHES == 1
    a.ph_lo = 0; a.ph_hi = NPHASE;
    hipLaunchKernelGGL(fwd_kernel, dim3(grid), dim3(NWAVES * 64), LDS_BYTES, stream, a);
#else
    for (int p = 0; p < NPHASE; ++p) { a.ph_lo = p; a.ph_hi = p + 1; hipLaunchKernelGGL(fwd_kernel, dim3(grid), dim3(NWAVES * 64), LDS_BYTES, stream, a); }
#endif
    const hipError_t le = hipPeekAtLastError();
    if (le != hipSuccess) fprintf(stderr, "kernel_launch: launch failed: %s\n", hipGetErrorName(le));
}
```
